# Optimizing an MI355X kernel written in HIP

```python
import math
import jax, jax.numpy as jnp
from jax import lax
import numpy as np

D_MODEL = 1024
BATCH = 8
SEQ = 4096
DEPTH = 2

GRID_W = 64
CTX_LEN = 256
EPS = 1e-6

A_W = D_MODEL // 4
A_GROUPS = 4
A_HORIZ = A_W // 2
G_HEADS = 4
G_DK = 128
G_DV = 128
QK_W = G_HEADS * G_DK
G_W = G_HEADS * G_DV
GDN_CHUNK = 64
C_GROUPS = 4
C_W = D_MODEL // 4
C_GD = C_W // C_GROUPS
C_CHUNK = 128
MIX_W = A_W + G_W + C_W
FFN_HIDDEN = ((8 * D_MODEL + 3 * 256 - 1) // (3 * 256)) * 256

OFF_A_B = 0
OFF_A_C = OFF_A_B + A_W
OFF_A_H = OFF_A_C + A_W
OFF_Q = OFF_A_H + A_W
OFF_K = OFF_Q + QK_W
OFF_V = OFF_K + QK_W
OFF_AB = OFF_V + G_W
OFF_Z = OFF_AB + 4 * G_HEADS
OFF_CU = OFF_Z + G_W
OFF_CV = OFF_CU + C_W
IN_COLS = OFF_CV + C_W

kernel_name = 'hybrid_conv_gdn_sgu_dit_block'


def _rmsnorm(a, g):
    a32 = a.astype(jnp.float32)
    y = a32 * lax.rsqrt(jnp.mean(a32 * a32, axis=-1, keepdims=True) + EPS) * g.astype(jnp.float32)
    return y.astype(a.dtype)


def _modulate(h, shift, scale):
    return h * (1 + scale) + shift


def _l2norm(a):
    a32 = a.astype(jnp.float32)
    return a32 * lax.rsqrt(jnp.sum(a32 * a32, axis=-1, keepdims=True) + EPS)


def _heads(a, dh):
    bn, t, _ = a.shape
    return a.reshape(bn, t, -1, dh).transpose(0, 2, 1, 3)


def _conv3_seq(a, w):
    ap = jnp.pad(a, ((0, 0), (1, 1), (0, 0)))
    return w[0] * ap[:, :-2] + w[1] * ap[:, 1:-1] + w[2] * ap[:, 2:]


def _conv3_grid(a, w):
    bn, t, ch = a.shape
    rows = t // GRID_W
    g = a.reshape(bn, rows, GRID_W, ch)
    wh, wv = w[:, :A_HORIZ], w[:, A_HORIZ:]
    gh = jnp.pad(g[..., :A_HORIZ], ((0, 0), (0, 0), (1, 1), (0, 0)))
    yh = wh[0] * gh[:, :, :-2] + wh[1] * gh[:, :, 1:-1] + wh[2] * gh[:, :, 2:]
    gv = jnp.pad(g[..., A_HORIZ:], ((0, 0), (1, 1), (0, 0), (0, 0)))
    yv = wv[0] * gv[:, :-2] + wv[1] * gv[:, 1:-1] + wv[2] * gv[:, 2:]
    return jnp.concatenate([yh, yv], axis=-1).reshape(bn, t, ch)


def _delta_update(s, w_c, u_c, kt_c, gl_c):
    v_new = u_c - jnp.einsum('bhck,bhkv->bhcv', w_c, s)
    s_new = s * jnp.exp(gl_c)[..., None, None] + jnp.einsum('bhck,bhcv->bhkv', kt_c, v_new)
    return v_new, s_new


def _gdn_scan(q, k, v, g, beta, s0):
    bn, h, t, _ = k.shape
    dv = v.shape[-1]
    n = t // GDN_CHUNK

    def chunks(a):
        a = a.astype(jnp.float32).reshape(bn, h, n, GDN_CHUNK, *a.shape[3:])
        return jnp.moveaxis(a, 2, 0)

    kc, vc, gc, bc = chunks(k), chunks(v), chunks(g), chunks(beta)
    gcum = jnp.cumsum(gc, axis=-1)
    idx = jnp.arange(GDN_CHUNK)
    causal = idx[:, None] >= idx[None, :]
    strict = idx[:, None] > idx[None, :]
    dmat = jnp.exp(jnp.where(causal, gcum[..., :, None] - gcum[..., None, :], -jnp.inf))
    kkt = jnp.einsum('nbhck,nbhdk->nbhcd', kc, kc)
    m = jnp.eye(GDN_CHUNK, dtype=jnp.float32) + jnp.where(strict, kkt * dmat * bc[..., None], 0.0)
    rhs = jnp.concatenate([vc * bc[..., None], kc * (bc * jnp.exp(gcum))[..., None]], axis=-1)
    sol = lax.linalg.triangular_solve(m, rhs, left_side=True, lower=True, unit_diagonal=True)
    u, w = sol[..., :dv], sol[..., dv:]
    g_last = gcum[..., -1]
    k_tail = kc * jnp.exp(g_last[..., None] - gcum)[..., None]
    s0 = s0.astype(jnp.float32)

    if q is None:
        def step_state(s, xs):
            w_c, u_c, kt_c, gl_c = xs
            _, s_new = _delta_update(s, w_c, u_c, kt_c, gl_c)
            return s_new, None
        s_fin, _ = lax.scan(step_state, s0, (w, u, k_tail, g_last))
        return None, s_fin

    qc = chunks(q)
    qk = jnp.einsum('nbhck,nbhdk->nbhcd', qc, kc) * dmat
    q_dec = qc * jnp.exp(gcum)[..., None]

    def step(s, xs):
        w_c, u_c, kt_c, gl_c, qd_c, qk_c = xs
        v_new, s_new = _delta_update(s, w_c, u_c, kt_c, gl_c)
        o = jnp.einsum('bhck,bhkv->bhcv', qd_c, s) + jnp.einsum('bhcd,bhdv->bhcv', qk_c, v_new)
        return s_new, o

    s_fin, o = lax.scan(step, s0, (w, u, k_tail, g_last, q_dec, qk))
    o = jnp.moveaxis(o, 0, 2).reshape(bn, h, t, dv)
    return o, s_fin


def _flip_t(a):
    return None if a is None else jnp.flip(a, axis=2)


def _gdn_bidir(q, k, v, g, beta, s0f, s0b):
    of, sf = _gdn_scan(q, k, v, g[0], beta[0], s0f)
    ob, sb = _gdn_scan(_flip_t(q), _flip_t(k), _flip_t(v), _flip_t(g[1]), _flip_t(beta[1]), s0b)
    o = None if q is None else of + _flip_t(ob)
    return o, sf, sb


def _gdn_kv(k_raw, v_raw, ab, conv_k, conv_v, a_log, dt_bias):
    bn, t, _ = k_raw.shape
    k = _l2norm(_heads(jax.nn.silu(_conv3_seq(k_raw, conv_k)), G_DK))
    v = _heads(jax.nn.silu(_conv3_seq(v_raw, conv_v)), G_DV).astype(jnp.float32)
    ab = ab.astype(jnp.float32).reshape(bn, t, 4, G_HEADS)
    beta = jax.nn.sigmoid(ab[:, :, :2])
    g = -jnp.exp(a_log.astype(jnp.float32)) * jax.nn.softplus(ab[:, :, 2:] + dt_bias.astype(jnp.float32))
    return k, v, jnp.transpose(g, (2, 0, 3, 1)), jnp.transpose(beta, (2, 0, 3, 1))


def _gated_out(o, z, gw):
    bn, t, _ = z.shape
    o = jnp.transpose(o, (0, 2, 1, 3))
    o = o * lax.rsqrt(jnp.mean(o * o, axis=-1, keepdims=True) + EPS) * gw.astype(jnp.float32)
    o = o * jax.nn.silu(z.astype(jnp.float32).reshape(bn, t, G_HEADS, G_DV))
    return o.reshape(bn, t, G_W).astype(z.dtype)


def _chunk_sgu(u, v, ln_g, ln_b, w_s, b_s):
    u = jax.nn.gelu(u, approximate=False)
    v32 = jax.nn.gelu(v, approximate=False).astype(jnp.float32)
    mu = jnp.mean(v32, axis=-1, keepdims=True)
    var = jnp.mean(jnp.square(v32 - mu), axis=-1, keepdims=True)
    v = ((v32 - mu) * lax.rsqrt(var + EPS) * ln_g.astype(jnp.float32) + ln_b.astype(jnp.float32)).astype(u.dtype)
    bn, t, _ = v.shape
    vc = v.reshape(bn, t // C_CHUNK, C_CHUNK, C_GROUPS, C_GD)
    mixed = jnp.einsum('gpq,bnqgc->bnpgc', w_s, vc) + b_s.T[None, None, :, :, None]
    return u * mixed.reshape(bn, t, C_W)


def _mixers(p, conv_fn, conv_a, conv_qkv, a_log, dt_bias, g_onorm, ln_g, ln_b, w_s, b_s, s0f, s0b):
    y_a = p[..., OFF_A_B:OFF_A_C] * conv_fn(p[..., OFF_A_C:OFF_A_H] * p[..., OFF_A_H:OFF_Q], conv_a)
    q = _l2norm(_heads(jax.nn.silu(_conv3_seq(p[..., OFF_Q:OFF_K], conv_qkv[:, :QK_W])), G_DK)) * (G_DK ** -0.5)
    k, v, g, beta = _gdn_kv(p[..., OFF_K:OFF_V], p[..., OFF_V:OFF_AB], p[..., OFF_AB:OFF_Z],
                            conv_qkv[:, QK_W:2 * QK_W], conv_qkv[:, 2 * QK_W:], a_log, dt_bias)
    o, sf, sb = _gdn_bidir(q, k, v, g, beta, s0f, s0b)
    y_b = _gated_out(o, p[..., OFF_Z:OFF_CU], g_onorm)
    y_c = _chunk_sgu(p[..., OFF_CU:OFF_CV], p[..., OFF_CV:IN_COLS], ln_g, ln_b, w_s, b_s)
    return jnp.concatenate([y_a, y_b, y_c], axis=-1), sf, sb


def _ffn_sublayer(s, shift, scale, gate, g_pre, g_post, w1, w2):
    h = _modulate(_rmsnorm(s, g_pre), shift, scale)
    gu = h @ w1
    y = (jax.nn.silu(gu[..., :FFN_HIDDEN]) * gu[..., FFN_HIDDEN:]) @ w2
    return s + gate * _rmsnorm(y, g_post)


def setup_inputs(seed: int = 0) -> dict:
    key = jax.random.key(seed)
    ks = jax.random.split(key, 24)
    L = DEPTH

    def nrm(k, shape, s):
        return jax.random.normal(k, shape, jnp.float32) * s

    dt = jnp.exp(jax.random.uniform(ks[14], (L, 2, G_HEADS), jnp.float32, math.log(1e-3), math.log(1e-1)))
    return {
        'x': nrm(ks[0], (BATCH, SEQ, D_MODEL), 1.0),
        'c': nrm(ks[1], (BATCH, D_MODEL), 1.0),
        'ctx': nrm(ks[2], (BATCH, CTX_LEN, D_MODEL), 1.0),
        'c_ctx': nrm(ks[3], (D_MODEL,), 1.0),
        'w_mod': nrm(ks[4], (L, D_MODEL, 6 * D_MODEL), 0.5 * D_MODEL ** -0.5),
        'b_mod': nrm(ks[5], (L, 6 * D_MODEL), 0.02),
        'g_pre_mix': 1.0 + nrm(ks[6], (L, D_MODEL), 0.02),
        'g_post_mix': 1.0 + nrm(ks[7], (L, D_MODEL), 0.02),
        'g_pre_ffn': 1.0 + nrm(ks[8], (L, D_MODEL), 0.02),
        'g_post_ffn': 1.0 + nrm(ks[9], (L, D_MODEL), 0.02),
        'w_in': nrm(ks[10], (L, D_MODEL, IN_COLS), D_MODEL ** -0.5),
        'conv_a': nrm(ks[11], (L, 3, A_W), 3 ** -0.5),
        'conv_qkv': nrm(ks[12], (L, 3, 2 * QK_W + G_W), 3 ** -0.5),
        'a_log': jnp.log(jax.random.uniform(ks[13], (L, 2, G_HEADS), jnp.float32, 1.0, 16.0)),
        'dt_bias': dt + jnp.log(-jnp.expm1(-dt)),
        'g_onorm': 1.0 + nrm(ks[15], (L, G_DV), 0.02),
        'ln_c_g': 1.0 + nrm(ks[16], (L, C_W), 0.02),
        'ln_c_b': nrm(ks[17], (L, C_W), 0.02),
        'w_s': nrm(ks[18], (L, C_GROUPS, C_CHUNK, C_CHUNK), C_CHUNK ** -0.5),
        'b_s': 1.0 + nrm(ks[19], (L, C_GROUPS, C_CHUNK), 0.1),
        'w_o': nrm(ks[20], (L, MIX_W, D_MODEL), MIX_W ** -0.5),
        'w_ffn_in': nrm(ks[21], (L, D_MODEL, 2 * FFN_HIDDEN), D_MODEL ** -0.5),
        'w_ffn_out': nrm(ks[22], (L, FFN_HIDDEN, D_MODEL), FFN_HIDDEN ** -0.5),
    }


def reference(x, c, ctx, c_ctx, w_mod, b_mod, g_pre_mix, g_post_mix, g_pre_ffn, g_post_ffn, w_in,
              conv_a, conv_qkv, a_log, dt_bias, g_onorm, ln_c_g, ln_c_b, w_s, b_s, w_o, w_ffn_in, w_ffn_out):
    bn = x.shape[0]
    s_zero = jnp.zeros((bn, G_HEADS, G_DK, G_DV), jnp.float32)
    for l in range(DEPTH):
        last = l == DEPTH - 1
        mx = jnp.split((jax.nn.silu(c) @ w_mod[l] + b_mod[l])[:, None, :], 6, axis=-1)
        mc = jnp.split(jax.nn.silu(c_ctx) @ w_mod[l] + b_mod[l], 6, axis=-1)

        hc = _modulate(_rmsnorm(ctx, g_pre_mix[l]), mc[0], mc[1])
        if last:
            pkv = hc @ w_in[l][:, OFF_K:OFF_Z]
            k_c, v_c, g_c, b_c = _gdn_kv(pkv[..., :QK_W], pkv[..., QK_W:QK_W + G_W], pkv[..., QK_W + G_W:],
                                         conv_qkv[l][:, QK_W:2 * QK_W], conv_qkv[l][:, 2 * QK_W:],
                                         a_log[l], dt_bias[l])
            _, sf, sb = _gdn_bidir(None, k_c, v_c, g_c, b_c, s_zero, s_zero)
        else:
            yc, sf, sb = _mixers(hc @ w_in[l], _conv3_seq, conv_a[l], conv_qkv[l], a_log[l], dt_bias[l],
                                 g_onorm[l], ln_c_g[l], ln_c_b[l], w_s[l], b_s[l], s_zero, s_zero)

        hx = _modulate(_rmsnorm(x, g_pre_mix[l]), mx[0], mx[1])
        yx, _, _ = _mixers(hx @ w_in[l], _conv3_grid, conv_a[l], conv_qkv[l], a_log[l], dt_bias[l],
                           g_onorm[l], ln_c_g[l], ln_c_b[l], w_s[l], b_s[l], sf, sb)
        x = x + mx[2] * _rmsnorm(yx @ w_o[l], g_post_mix[l])
        x = _ffn_sublayer(x, mx[3], mx[4], mx[5], g_pre_ffn[l], g_post_ffn[l], w_ffn_in[l], w_ffn_out[l])

        if not last:
            ctx = ctx + mc[2] * _rmsnorm(yc @ w_o[l], g_post_mix[l])
            ctx = _ffn_sublayer(ctx, mc[3], mc[4], mc[5], g_pre_ffn[l], g_post_ffn[l], w_ffn_in[l], w_ffn_out[l])
    return x
```

```cpp
#include <hip/hip_runtime.h>
#include <hip/hip_cooperative_groups.h>
#include <cstdio>
#include <cstdint>
namespace cg = cooperative_groups;

__device__ __forceinline__ int opaque_tid() { int t = threadIdx.x; asm volatile("" : "+v"(t)); return t; }
__device__ __forceinline__ int opaque_bid() { int t = blockIdx.x; asm volatile("" : "+s"(t)); return t; }
namespace pg8 {
#define PG8_LAS __attribute__((address_space(3)))
typedef unsigned short bf16_t;
typedef short bf16x8 __attribute__((ext_vector_type(8)));
typedef float f32x4 __attribute__((ext_vector_type(4)));
typedef unsigned u32x4 __attribute__((ext_vector_type(4)));
constexpr int BM = 256, BK = 64, HALF = 128, HTB = HALF * BK * 2  , STAGE_BYTES = 8 * HTB, NXCD = 8, WGM = 8;

__host__ __device__ __forceinline__ int lds_byte(int r, int c) { const int st = (r >> 4) * 2 + (c >> 5), rr = r & 15, cc = c & 31, ob = rr * 64 + cc * 2; return st * 1024 + (ob ^ (((ob >> 9) & 1) << 5)); }
__host__ __device__ __forceinline__ void stage_rc(int b, int& R, int& C) { const int st = b / 1024, sb = b % 1024, swz = sb ^ (((sb >> 9) & 1) << 5); R = (st >> 1) * 16 + swz / 64; C = (st & 1) * 32 + (swz % 64) / 2; }
__host__ __device__ __forceinline__ int perm32(int rho) { const int n = rho >> 4, i = rho & 15; return 8 * (i >> 2) + 4 * n + (i & 3); }

struct Unit { int pm, pn; };
struct Gemm { const bf16_t* A; const bf16_t* Bt; int M, N, K, ld; };

struct StaticOrder {
    int nM, nN, nwg, G, c;
    __host__ __device__ void init(int M, int N, int G_, int c_) { nM = M / BM; nN = N / BM; nwg = nM * nN; G = G_; c = c_; }
    __host__ __device__ bool next(int i, Unit& u) const {
        const long L = (long)i * G + c; if (L >= nwg) return false;
        int wgid = (int)L; { const int q = nwg / NXCD, r = nwg % NXCD, xcd = wgid % NXCD, off = wgid / NXCD; wgid = (xcd < r ? xcd * (q + 1) : r * (q + 1) + (xcd - r) * q) + off; }
        const int nig = WGM * nN, gid = wgid / nig, fm = gid * WGM, gsz = (nM - fm) < WGM ? (nM - fm) : WGM;
        u.pm = fm + ((wgid % nig) % gsz); u.pn = (wgid % nig) / gsz; return true;
    }
    __device__ __forceinline__ void a_ready(const Unit&) const {}
    __device__ __forceinline__ void done(const Unit&) const {}
};

template <class Epi, class Sched, bool ALIGN_EPI = false, bool SP2 = false>
__device__ __forceinline__ void gemm_phase(PG8_LAS unsigned char* lds, const Gemm g, const Sched& S, const Epi& E) {
    const int tid = opaque_tid(), wid = __builtin_amdgcn_readfirstlane(tid >> 6), lane = tid & 63, wr = wid >> 2, wc = wid & 3, fr = lane & 15, fq = lane >> 4;
    const int K = g.ld, nt = g.K / BK;
    unsigned voffA[2], voffB[2];
#pragma unroll
    for (int i = 0; i < 2; ++i) { int R, C; stage_rc(tid * 16 + i * 8192, R, C); const int Rb = Epi::PERM ? ((R & ~31) + perm32(R & 31)) : R;
        voffA[i] = (unsigned)(R * K + C) * 2u; voffB[i] = (unsigned)(Rb * K + C) * 2u; }
    const size_t kstep = (size_t)(BK * 2);
    const size_t hstep = (size_t)HALF * K * 2;
    const size_t tstep = 2 * hstep;
    const unsigned ldsw = (unsigned)wid * 1024u;
    const int aoff = lds_byte(wr * 64 + fr, fq * 8), boff = lds_byte(wc * 32 + fr, fq * 8);
#define PG8_SA(b, h) (((b) * 2 + (h)) * HTB)
#define PG8_SB(b, h) ((4 + (b) * 2 + (h)) * HTB)
#define PG8_STAGE(bufoff, gbase, voff) do { _Pragma("unroll") for (int _i = 0; _i < 2; ++_i) \
        __builtin_amdgcn_global_load_lds((const unsigned*)((const char*)(gbase) + (voff)[_i]), (PG8_LAS unsigned*)(lds + (bufoff) + ldsw + _i * 8192), 16, 0, 0); } while (0)
#define PG8_LDA(dst, b, h) do { _Pragma("unroll") for (int m = 0; m < 4; ++m) _Pragma("unroll") for (int k = 0; k < 2; ++k) dst[m][k] = *(const PG8_LAS bf16x8*)(lds + PG8_SA(b, h) + aoff + m * 2048 + k * 1024); } while (0)
#define PG8_LDB(dst, b, h) do { _Pragma("unroll") for (int n = 0; n < 2; ++n) _Pragma("unroll") for (int k = 0; k < 2; ++k) dst[n][k] = *(const PG8_LAS bf16x8*)(lds + PG8_SB(b, h) + boff + n * 2048 + k * 1024); } while (0)
#define PG8_MMA(ai, bj, At, Bt) do { __builtin_amdgcn_s_setprio(1); _Pragma("unroll") for (int m = 0; m < 4; ++m) _Pragma("unroll") for (int n = 0; n < 2; ++n) _Pragma("unroll") for (int k = 0; k < 2; ++k) \
        acc[ai][bj][m][n] = __builtin_amdgcn_mfma_f32_16x16x32_bf16(Bt[n][k], At[m][k], acc[ai][bj][m][n], 0, 0, 0); __builtin_amdgcn_s_setprio(0); } while (0)
#define PG8_WAIT_V(n) asm volatile("s_waitcnt vmcnt(" #n ")" ::: "memory")
#define PG8_WAIT_L(n) asm volatile("s_waitcnt lgkmcnt(" #n ")" ::: "memory")
#define PG8_BAR __builtin_amdgcn_s_barrier()
#define PG8_SCHED __builtin_amdgcn_sched_barrier(0)
    Unit cur, nxt; int ui = 0;
    if (!S.next(0, cur)) return;
    f32x4 acc[2][2][4][2];
#pragma unroll
    for (int a = 0; a < 2; ++a)
#pragma unroll
        for (int b = 0; b < 2; ++b)
#pragma unroll
            for (int m = 0; m < 4; ++m)
#pragma unroll
                for (int n = 0; n < 2; ++n) acc[a][b][m][n] = (f32x4){0.f, 0.f, 0.f, 0.f};
    bf16x8 At[4][2], B0[2][2], B1[2][2];
    const char* cA = (const char*)g.A + (size_t)cur.pm * tstep; const char* cB = (const char*)g.Bt + (size_t)cur.pn * tstep;
    S.a_ready(cur);
    if constexpr (SP2) {
        PG8_STAGE(PG8_SB(0, 0), cB, voffB); PG8_STAGE(PG8_SB(0, 1), cB + hstep, voffB); PG8_STAGE(PG8_SA(0, 0), cA, voffA); PG8_STAGE(PG8_SA(0, 1), cA + hstep, voffA);
        if (wr == 1) PG8_BAR;
        PG8_WAIT_V(2); PG8_BAR;
        PG8_STAGE(PG8_SB(1, 0), cB + kstep, voffB); PG8_STAGE(PG8_SA(1, 0), cA + kstep, voffA); PG8_STAGE(PG8_SB(1, 1), cB + hstep + kstep, voffB);
        PG8_WAIT_V(6); PG8_BAR;
    } else {
        PG8_STAGE(PG8_SB(0, 0), cB, voffB); PG8_STAGE(PG8_SA(0, 0), cA, voffA); PG8_STAGE(PG8_SB(0, 1), cB + hstep, voffB); PG8_STAGE(PG8_SA(0, 1), cA + hstep, voffA);
        if (wr == 1) PG8_BAR;
        PG8_WAIT_V(4); PG8_BAR;
        PG8_STAGE(PG8_SB(1, 0), cB + kstep, voffB); PG8_STAGE(PG8_SA(1, 0), cA + kstep, voffA); PG8_STAGE(PG8_SB(1, 1), cB + hstep + kstep, voffB);
        PG8_WAIT_V(6); PG8_BAR;
    }
    for (;;) {
        const bool has_next = S.next(ui + 1, nxt);
        const char* nA = has_next ? (const char*)g.A + (size_t)nxt.pm * tstep : cA; const char* nB = has_next ? (const char*)g.Bt + (size_t)nxt.pn * tstep : cB;
        for (int t = 0; t < nt; t += 2) {
            const bool last = (t == nt - 2);
            const char* a1 = cA + (size_t)(t + 1) * kstep;
            const char* a2 = last ? nA : cA + (size_t)(t + 2) * kstep; const char* b2 = last ? nB : cB + (size_t)(t + 2) * kstep;
            const char* a3 = a2 + kstep; const char* b3 = b2 + kstep;
            if (last && has_next) S.a_ready(nxt);
            if constexpr (SP2) {
            PG8_LDB(B0, 0, 0); PG8_LDB(B1, 0, 1); PG8_SCHED; PG8_LDA(At, 0, 0); PG8_STAGE(PG8_SA(1, 1), a1 + hstep, voffA);
            PG8_WAIT_V(8); PG8_WAIT_L(0); PG8_BAR; PG8_MMA(0, 0, At, B0); PG8_MMA(0, 1, At, B1); PG8_BAR; PG8_SCHED;
            PG8_LDA(At, 0, 1); PG8_STAGE(PG8_SB(0, 0), b2, voffB); PG8_STAGE(PG8_SB(0, 1), b2 + hstep, voffB); PG8_STAGE(PG8_SA(0, 0), a2, voffA);
            PG8_WAIT_V(8); PG8_WAIT_L(0); PG8_BAR; PG8_MMA(1, 0, At, B0); PG8_MMA(1, 1, At, B1); PG8_BAR; PG8_SCHED;
            PG8_LDB(B0, 1, 0); PG8_LDB(B1, 1, 1); PG8_SCHED; PG8_LDA(At, 1, 0); PG8_STAGE(PG8_SA(0, 1), a2 + hstep, voffA);
            PG8_WAIT_V(8); PG8_WAIT_L(0); PG8_BAR; PG8_MMA(0, 0, At, B0); PG8_MMA(0, 1, At, B1); PG8_BAR; PG8_SCHED;
            PG8_LDA(At, 1, 1); PG8_STAGE(PG8_SB(1, 0), b3, voffB); PG8_STAGE(PG8_SB(1, 1), b3 + hstep, voffB); PG8_STAGE(PG8_SA(1, 0), a3, voffA);
            PG8_WAIT_V(8); PG8_WAIT_L(0); PG8_BAR; PG8_MMA(1, 0, At, B0); PG8_MMA(1, 1, At, B1); PG8_BAR; PG8_SCHED;
            } else {
            PG8_LDB(B0, 0, 0); PG8_SCHED; PG8_LDA(At, 0, 0); PG8_STAGE(PG8_SA(1, 1), a1 + hstep, voffA);
            PG8_WAIT_L(8); PG8_BAR; PG8_WAIT_L(0); PG8_MMA(0, 0, At, B0); PG8_BAR; PG8_SCHED;
            PG8_LDB(B1, 0, 1); PG8_STAGE(PG8_SB(0, 0), b2, voffB);
            PG8_BAR; PG8_WAIT_L(0); PG8_MMA(0, 1, At, B1); PG8_BAR;
            PG8_LDA(At, 0, 1); PG8_STAGE(PG8_SA(0, 0), a2, voffA);
            PG8_BAR; PG8_WAIT_L(0); PG8_MMA(1, 0, At, B0); PG8_BAR; PG8_SCHED;
            PG8_STAGE(PG8_SB(0, 1), b2 + hstep, voffB);
            PG8_WAIT_V(6); PG8_BAR; PG8_MMA(1, 1, At, B1); PG8_BAR;
            PG8_LDB(B0, 1, 0); PG8_SCHED; PG8_LDA(At, 1, 0); PG8_STAGE(PG8_SA(0, 1), a2 + hstep, voffA);
            PG8_WAIT_L(8); PG8_BAR; PG8_WAIT_L(0); PG8_MMA(0, 0, At, B0); PG8_BAR; PG8_SCHED;
            PG8_LDB(B1, 1, 1); PG8_STAGE(PG8_SB(1, 0), b3, voffB);
            PG8_BAR; PG8_WAIT_L(0); PG8_MMA(0, 1, At, B1); PG8_BAR;
            PG8_LDA(At, 1, 1); PG8_STAGE(PG8_SA(1, 0), a3, voffA);
            PG8_BAR; PG8_WAIT_L(0); PG8_MMA(1, 0, At, B0); PG8_BAR; PG8_SCHED;
            PG8_STAGE(PG8_SB(1, 1), b3 + hstep, voffB);
            PG8_WAIT_V(6); PG8_BAR; PG8_MMA(1, 1, At, B1); PG8_BAR;
            }
        }
        if constexpr (ALIGN_EPI) { if (wr == 0) PG8_BAR; }
        if constexpr (!Epi::AFTER_DRAIN) { E(acc, cur, wr, wc, fr, fq); S.done(cur); }
        if (!has_next) break;
#pragma unroll
        for (int a = 0; a < 2; ++a)
#pragma unroll
            for (int b = 0; b < 2; ++b)
#pragma unroll
                for (int m = 0; m < 4; ++m)
#pragma unroll
                    for (int n = 0; n < 2; ++n) acc[a][b][m][n] = (f32x4){0.f, 0.f, 0.f, 0.f};
        cur = nxt; cA = nA; cB = nB; ++ui;
        if constexpr (ALIGN_EPI) { if (wr == 1) PG8_BAR; }
    }
    PG8_WAIT_V(0);
    if constexpr (!ALIGN_EPI) { if (wr == 0) PG8_BAR; }
    PG8_BAR;
    if constexpr (Epi::AFTER_DRAIN) { E.fused(acc, cur, wr, wc, fr, fq, lds, wid, lane); S.done(cur); }
#undef PG8_SA
#undef PG8_SB
#undef PG8_STAGE
#undef PG8_LDA
#undef PG8_LDB
#undef PG8_MMA
#undef PG8_WAIT_V
#undef PG8_WAIT_L
#undef PG8_BAR
#undef PG8_SCHED
}
}

#define DI __device__ __forceinline__
typedef unsigned short bf16_t;
typedef short bf16x8 __attribute__((ext_vector_type(8)));
typedef float f32x2 __attribute__((ext_vector_type(2)));
typedef float f32x4 __attribute__((ext_vector_type(4)));
typedef float f32x16 __attribute__((ext_vector_type(16)));
typedef unsigned u32x2 __attribute__((ext_vector_type(2)));
typedef unsigned u32x4 __attribute__((ext_vector_type(4)));
typedef __bf16 bf16x2_t __attribute__((ext_vector_type(2)));

constexpr int DM = 1024, NB = 8, SEQL = 4096, CTXL = 256;
constexpr int RC = NB * CTXL, RX = NB * SEQL, RT = RC + RX;
constexpr int INC = 3344, NIN = 3584, FH = 2816, NF1 = 5632;
constexpr float EPSV = 1e-6f;
constexpr int LDS_BYTES = 155648;

constexpr size_t WS_WIN = 0;
constexpr size_t WS_WO  = WS_WIN + (size_t)NIN * 1024 * 2;
constexpr size_t WS_WF1 = WS_WO + (size_t)1024 * 1024 * 2;
constexpr size_t WS_WF2 = WS_WF1 + (size_t)NF1 * 1024 * 2;
constexpr size_t WS_MOD = WS_WF2 + (size_t)1024 * FH * 2;
constexpr size_t WS_XC  = WS_MOD + (size_t)2 * 9 * 6144 * 4;
constexpr size_t WS_AB  = WS_XC + (size_t)RC * 1024 * 4;
constexpr size_t WS_PA  = WS_AB + (size_t)RT * 16 * 4;
constexpr size_t WS_PQ  = WS_PA + (size_t)RT * 768 * 2;
constexpr size_t WS_PZ  = WS_PQ + (size_t)RT * 1536 * 2;
constexpr size_t WS_G   = WS_PZ + (size_t)RT * 1024 * 2;
constexpr int    UNIT_BYTES = 116736;
constexpr int    NUNITS = 544 * 4;
constexpr size_t WS_BAR = WS_G + (size_t)NUNITS * UNIT_BYTES;
constexpr size_t WS_CTXB = WS_BAR + 16384;
constexpr size_t WS_END = WS_CTXB + (size_t)RC * 1024 * 2;
constexpr size_t WS_H    = WS_G;
constexpr size_t WS_YMIX = WS_G + (size_t)RT * 1024 * 2;
constexpr size_t WS_Y2   = WS_G + (size_t)RT * 1024 * 2;
constexpr size_t WS_YO   = WS_PA;
constexpr size_t WS_HID  = WS_PA;
constexpr size_t WS_OF   = WS_PQ;
constexpr size_t WS_OB   = WS_PQ + (size_t)RT * 512 * 2;
constexpr size_t WS_YAC  = WS_PQ + (size_t)RT * 1024 * 2;
static_assert(WS_Y2 + (size_t)RT * 1024 * 4 <= WS_END, "Y2 overlay");
static_assert(WS_HID + (size_t)RT * FH * 2 <= WS_G, "HID overlay");
constexpr int OFF_Q = 0, OFF_KT = 16384, OFF_D0 = 32768, DIR_BYTES = 40960, OFF_W = 0, OFF_QK = 16384, OFF_U = 24576, OFF_SC = 114688, SC_BYTES = 528;
constexpr int SCAN_BUF = 74752;

struct Params {
    const float *x, *c, *ctx, *c_ctx, *w_mod, *b_mod, *g_pre_mix, *g_post_mix, *g_pre_ffn, *g_post_ffn, *w_in, *conv_a, *conv_qkv, *a_log, *dt_bias,
                *g_onorm, *ln_c_g, *ln_c_b, *w_s, *b_s, *w_o, *w_ffn_in, *w_ffn_out;
    float* out; unsigned char* ws;
    int ph_lo, ph_hi;
};

DI unsigned pkbf(float lo, float hi) { f32x2 v = {lo, hi}; return __builtin_bit_cast(unsigned, __builtin_convertvector(v, bf16x2_t)); }
DI bf16_t bf1(float x) { return (bf16_t)(pkbf(x, 0.f) & 0xffffu); }
DI float bflo(unsigned w) { return __uint_as_float(w << 16); }
DI float bfhi(unsigned w) { return __uint_as_float(w & 0xffff0000u); }
DI float bf2f(bf16_t b) { return __uint_as_float(((unsigned)b) << 16); }
DI void unpack8(const u32x4 w, float* o) { o[0] = bflo(w.x); o[1] = bfhi(w.x); o[2] = bflo(w.y); o[3] = bfhi(w.y); o[4] = bflo(w.z); o[5] = bfhi(w.z); o[6] = bflo(w.w); o[7] = bfhi(w.w); }
DI u32x4 packw8(const float* v) { u32x4 w; w.x = pkbf(v[0], v[1]); w.y = pkbf(v[2], v[3]); w.z = pkbf(v[4], v[5]); w.w = pkbf(v[6], v[7]); return w; }
DI bf16x8 pack16s(const f32x16& x, const int s) {
    u32x4 w;
    if (s == 0) { w.x = pkbf(x[0], x[1]); w.y = pkbf(x[2], x[3]); w.z = pkbf(x[4], x[5]); w.w = pkbf(x[6], x[7]); }
    else        { w.x = pkbf(x[8], x[9]); w.y = pkbf(x[10], x[11]); w.z = pkbf(x[12], x[13]); w.w = pkbf(x[14], x[15]); }
    return __builtin_bit_cast(bf16x8, w);
}
#define MFMA32(a, b, c) __builtin_amdgcn_mfma_f32_32x32x16_bf16((a), (b), (c), 0, 0, 0)
DI int crow(int reg, int h) { return (reg & 3) + 8 * (reg >> 2) + 4 * h; }
DI float wave_sum(float v) {
#pragma unroll
    for (int o = 1; o < 64; o <<= 1) v += __shfl_xor(v, o);
    return v;
}
DI float siluf(float x) { return x / (1.f + expf(-x)); }
DI float sigmf(float x) { return 1.f / (1.f + expf(-x)); }
DI float geluf(float x) { return 0.5f * x * (1.f + erff(x * 0.70710678118654752f)); }
DI float fsilu(float x) { return x * __builtin_amdgcn_rcpf(1.f + __expf(-x)); }
DI float fgelu(float v) {
    const float av = fabsf(v), t = __builtin_amdgcn_rcpf(av * 0.2316418882f + 1.0f);
    float q = t * 0.5307027145f + (-0.7265760135f); q = q * t + 0.7107068705f; q = q * t + (-0.142248368f); q = q * t + 0.127414796f; q = q * t;
    const float e = __builtin_amdgcn_exp2f((v * v) * (-0.72134752044f));
    const float m = v * (q * e);
    return v < 0.f ? m : v - m;
}
DI float softplusf(float x) { return x > 20.f ? x : log1pf(expf(x)); }
#define LDS_WAIT() asm volatile("s_waitcnt lgkmcnt(0)" ::: "memory")
#define LBAR() asm volatile("s_waitcnt lgkmcnt(0)\n\ts_barrier" ::: "memory")

struct EpiBf16Out {
    static constexpr bool PERM = true, AFTER_DRAIN = false;
    bf16_t* out; int ldc;
    DI void operator()(const pg8::f32x4 (&acc)[2][2][4][2], const pg8::Unit& u, int wr, int wc, int fr, int fq) const {
        const int row0 = u.pm * 256 + wr * 64 + fr, col0 = u.pn * 256 + wc * 32 + 8 * fq;
#pragma unroll
        for (int ai = 0; ai < 2; ++ai)
#pragma unroll
            for (int m = 0; m < 4; ++m) { bf16_t* rp = out + (size_t)(row0 + ai * 128 + m * 16) * ldc + col0;
#pragma unroll
                for (int bj = 0; bj < 2; ++bj) { const pg8::f32x4 v0 = acc[ai][bj][m][0], v1 = acc[ai][bj][m][1];
                    u32x4 w; w.x = pkbf(v0[0], v0[1]); w.y = pkbf(v0[2], v0[3]); w.z = pkbf(v1[0], v1[1]); w.w = pkbf(v1[2], v1[3]);
                    *(u32x4*)(rp + bj * 128) = w; } }
    }
};
struct EpiInProj {
    static constexpr bool PERM = true, AFTER_DRAIN = false;
    bf16_t *PA, *PQ, *PZ; float* AB;
    DI void operator()(const pg8::f32x4 (&acc)[2][2][4][2], const pg8::Unit& u, int wr, int wc, int fr, int fq) const {
        const int row0 = u.pm * 256 + wr * 64 + fr;
        if (u.pn == 13) {
            if (wc == 0 && fq < 2) {
#pragma unroll
                for (int ai = 0; ai < 2; ++ai)
#pragma unroll
                    for (int m = 0; m < 4; ++m)
#pragma unroll
                        for (int n = 0; n < 2; ++n) *(pg8::f32x4*)(AB + (size_t)(row0 + ai * 128 + m * 16) * 16 + 8 * fq + 4 * n) = acc[ai][0][m][n];
            }
            return;
        }
        bf16_t* base; int ldc, coff;
        if (u.pn < 3) { base = PA; ldc = 768; coff = 256 * u.pn; }
        else if (u.pn < 9) { base = PQ; ldc = 1536; coff = 256 * (u.pn - 3); }
        else { base = PZ; ldc = 1024; coff = 256 * (u.pn - 9); }
        const int col0 = coff + wc * 32 + 8 * fq;
#pragma unroll
        for (int ai = 0; ai < 2; ++ai)
#pragma unroll
            for (int m = 0; m < 4; ++m) { bf16_t* rp = base + (size_t)(row0 + ai * 128 + m * 16) * ldc + col0;
#pragma unroll
                for (int bj = 0; bj < 2; ++bj) { const pg8::f32x4 v0 = acc[ai][bj][m][0], v1 = acc[ai][bj][m][1];
                    u32x4 w; w.x = pkbf(v0[0], v0[1]); w.y = pkbf(v0[2], v0[3]); w.z = pkbf(v1[0], v1[1]); w.w = pkbf(v1[2], v1[3]);
                    *(u32x4*)(rp + bj * 128) = w; } }
    }
};
struct EpiSwiglu {
    static constexpr bool PERM = true, AFTER_DRAIN = false;
    bf16_t* hid;
    DI void operator()(const pg8::f32x4 (&acc)[2][2][4][2], const pg8::Unit& u, int wr, int wc, int fr, int fq) const {
        const int row0 = u.pm * 256 + wr * 64 + fr, col0 = u.pn * 128 + wc * 32 + 8 * fq;
#pragma unroll
        for (int ai = 0; ai < 2; ++ai)
#pragma unroll
            for (int m = 0; m < 4; ++m) {
                float o[8];
#pragma unroll
                for (int n = 0; n < 2; ++n)
#pragma unroll
                    for (int j = 0; j < 4; ++j) { const float g = acc[ai][0][m][n][j], uu = acc[ai][1][m][n][j]; o[4 * n + j] = fsilu(g) * uu; }
                *(u32x4*)(hid + (size_t)(row0 + ai * 128 + m * 16) * FH + col0) = packw8(o);
            }
    }
};

DI void phase_mod(const Params& p, unsigned char* lds) {
    float* sc = (float*)lds;
    float* red = sc + 9 * 1024;
    float* MOD = (float*)(p.ws + WS_MOD);
    const int tid = opaque_tid();
    for (int it = opaque_bid(); it < 192; it += gridDim.x) {
        for (int i = tid; i < 9 * 1024; i += 512) { const int s = i >> 10, k = i & 1023; const float v = (s < 8) ? p.c[s * 1024 + k] : p.c_ctx[k]; sc[i] = siluf(v); }
        __syncthreads();
        const int l = it / 96, n0 = (it % 96) * 64, nn = tid & 63, kg = tid >> 6;
        const float* w = p.w_mod + ((size_t)l * 1024 + kg * 128) * 6144 + n0 + nn;
        float a[9];
#pragma unroll
        for (int s = 0; s < 9; ++s) a[s] = 0.f;
#pragma unroll 32
        for (int k = 0; k < 128; ++k) { const float wv = __builtin_nontemporal_load(w + (size_t)k * 6144);
#pragma unroll
            for (int s = 0; s < 9; ++s) a[s] += sc[s * 1024 + kg * 128 + k] * wv; }
#pragma unroll
        for (int s = 0; s < 9; ++s) red[(kg * 9 + s) * 64 + nn] = a[s];
        __syncthreads();
        for (int i = tid; i < 576; i += 512) { const int s = i >> 6, n2 = i & 63; float v = p.b_mod[l * 6144 + n0 + n2];
#pragma unroll
            for (int k2 = 0; k2 < 8; ++k2) v += red[(k2 * 9 + s) * 64 + n2];
            MOD[(size_t)(l * 9 + s) * 6144 + n0 + n2] = v; }
        __syncthreads();
    }
}
template <int MAP> DI int rowmap(int n) {
    if (MAP == 1) return n < 2304 ? n : (n < 2320 ? 3328 + (n - 2304) : n - 16);
    if (MAP == 2) { if (n < FH) return 256 * (n >> 7) + (n & 127); const int m = n - FH; return 256 * (m >> 7) + 128 + (m & 127); }
    return n;
}
template <int MAP> DI void tr_item(const float* W, int K, int N, bf16_t* WT, float* scr, int item, int lane) {
    const int nblk = (N + 31) / 32, kb = item / nblk, nb = item % nblk, k0 = 64 * kb, n0 = 32 * nb;
    const int nl = n0 + (lane & 31);
    float tv[32];
#pragma unroll
    for (int i = 0; i < 32; ++i) { const int kk = 2 * i + (lane >> 5); tv[i] = nl < N ? __builtin_nontemporal_load(W + (size_t)(k0 + kk) * N + nl) : 0.f; }
#pragma unroll
    for (int i = 0; i < 32; ++i) { const int kk = 2 * i + (lane >> 5); scr[kk * 33 + (lane & 31)] = tv[i]; }
    LDS_WAIT();
    const int c8 = lane & 7;
#pragma unroll
    for (int j = 0; j < 4; ++j) { const int n = (lane >> 3) + 8 * j; const float* s = scr + (8 * c8) * 33 + n;
        u32x4 o; o.x = pkbf(s[0], s[33]); o.y = pkbf(s[66], s[99]); o.z = pkbf(s[132], s[165]); o.w = pkbf(s[198], s[231]);
        if (n0 + n < N) *(u32x4*)(WT + (size_t)rowmap<MAP>(n0 + n) * K + k0 + 8 * c8) = o; }
    LDS_WAIT();
}
template <int PART> DI void phase_convert(const Params& p, int l, unsigned char* lds, int b0 = 0, int nb = 0) {
    const int tid = opaque_tid(), lane = tid & 63, wave = tid >> 6;
    float* scr = (float*)(lds + 65536) + wave * (64 * 33);
    bf16_t* WIN = (bf16_t*)(p.ws + WS_WIN); bf16_t* WO = (bf16_t*)(p.ws + WS_WO); bf16_t* WF1 = (bf16_t*)(p.ws + WS_WF1); bf16_t* WF2 = (bf16_t*)(p.ws + WS_WF2);
    constexpr int I_IN = 16 * 105, I_O = 16 * 32, I_F1 = 16 * 176, I_F2 = 44 * 32, NIT = I_IN + I_O + I_F1 + I_F2;
    const int gw = (PART == 0 ? opaque_bid() : opaque_bid() - b0) * 8 + wave, NGW = (PART == 0 ? (int)gridDim.x : nb) * 8;
    for (int it = (PART == 0 ? 0 : I_IN) + gw; it < (PART == 0 ? I_IN : NIT); it += NGW) {
        int r = it;
        if (r < I_IN) { tr_item<1>(p.w_in + (size_t)l * 1024 * INC, 1024, INC, WIN, scr, r, lane); continue; } r -= I_IN;
        if (r < I_O) { tr_item<0>(p.w_o + (size_t)l * 1024 * 1024, 1024, 1024, WO, scr, r, lane); continue; } r -= I_O;
        if (r < I_F1) { tr_item<2>(p.w_ffn_in + (size_t)l * 1024 * NF1, 1024, NF1, WF1, scr, r, lane); continue; } r -= I_F1;
        tr_item<0>(p.w_ffn_out + (size_t)l * FH * 1024, FH, 1024, WF2, scr, r, lane);
    }
    if (PART == 0) {
        u32x4* z = (u32x4*)(WIN + (size_t)INC * 1024);
        unsigned zz = 0u; asm volatile("" : "+v"(zz));
        const u32x4 zero = {zz, zz, zz, zz};
        for (int i = opaque_bid() * 512 + tid; i < (NIN - INC) * 1024 / 8; i += gridDim.x * 512) z[i] = zero;
    }
}

template <int MODE, bool WRITE_H> DI void rowpass(int row_lo, const float* xin_x, const float* xin_c, const bf16_t* Y, const bf16_t* Yb, const float* g_post, const float* mod_gate, int gate_idx,
                                    float* xout_x, float* xout_c, const float* g_pre, const float* mod_h, int shift_idx, bf16_t* H) {
    const int tid = opaque_tid(), lane = tid & 63, wave = tid >> 6;
    const int gw = opaque_bid() * 8 + wave, NGW = gridDim.x * 8;
    constexpr int NR = 4;
    for (int r0 = row_lo + gw * NR; r0 < RT; r0 += NGW * NR) {
        const int slot = r0 < RC ? 8 : ((r0 - RC) >> 12);
        const float* xr0 = r0 < RC ? xin_c + (size_t)r0 * 1024 : xin_x + (size_t)(r0 - RC) * 1024;
        f32x4 v[NR][4];
#pragma unroll
        for (int i = 0; i < NR; ++i)
#pragma unroll
            for (int j = 0; j < 4; ++j) v[i][j] = __builtin_nontemporal_load((const f32x4*)(xr0 + (size_t)i * 1024 + 4 * lane + 256 * j));
        u32x2 yw[NR][4]; f32x4 gp[4], gt[4], gpre[4], s1[4], s0[4];
        if (MODE == 1) {
            const float* gtp = mod_gate + (size_t)slot * 6144 + gate_idx * 1024;
#pragma unroll
            for (int i = 0; i < NR; ++i)
#pragma unroll
                for (int j = 0; j < 4; ++j) yw[i][j] = __builtin_nontemporal_load((const u32x2*)(Y + (size_t)(r0 + i) * 1024 + 4 * lane + 256 * j));
            if (Yb != nullptr && r0 < RC) {
                const bf16_t* Ybo = Yb; asm volatile("" : "+s"(Ybo));
#pragma unroll
                for (int i = 0; i < NR; ++i)
#pragma unroll
                    for (int j = 0; j < 4; ++j) { const u32x2 w2 = *(const u32x2*)(Ybo + (size_t)(r0 + i) * 1024 + 4 * lane + 256 * j);
                        yw[i][j].x = pkbf(bflo(yw[i][j].x) + bflo(w2.x), bfhi(yw[i][j].x) + bfhi(w2.x)); yw[i][j].y = pkbf(bflo(yw[i][j].y) + bflo(w2.y), bfhi(yw[i][j].y) + bfhi(w2.y)); }
            }
#pragma unroll
            for (int j = 0; j < 4; ++j) { gp[j] = *(const f32x4*)(g_post + 4 * lane + 256 * j); gt[j] = *(const f32x4*)(gtp + 4 * lane + 256 * j); }
        }
        if (WRITE_H) {
            const float* sh = mod_h + (size_t)slot * 6144 + shift_idx * 1024;
#pragma unroll
            for (int j = 0; j < 4; ++j) { gpre[j] = *(const f32x4*)(g_pre + 4 * lane + 256 * j); s0[j] = *(const f32x4*)(sh + 4 * lane + 256 * j); s1[j] = *(const f32x4*)(sh + 1024 + 4 * lane + 256 * j); }
        }
        if (MODE == 1) {
            float ss[NR];
#pragma unroll
            for (int i = 0; i < NR; ++i) { ss[i] = 0.f;
#pragma unroll
                for (int j = 0; j < 4; ++j) { const float a = bflo(yw[i][j].x), b2 = bfhi(yw[i][j].x), c2 = bflo(yw[i][j].y), d2 = bfhi(yw[i][j].y); ss[i] += (a * a + b2 * b2) + (c2 * c2 + d2 * d2); } }
#pragma unroll
            for (int o = 1; o < 64; o <<= 1) {
#pragma unroll
                for (int i = 0; i < NR; ++i) ss[i] += __shfl_xor(ss[i], o); }
            float* xo0 = r0 < RC ? xout_c + (size_t)r0 * 1024 : xout_x + (size_t)(r0 - RC) * 1024;
#pragma unroll
            for (int i = 0; i < NR; ++i) { const float rstd = rsqrtf(ss[i] * (1.f / 1024.f) + EPSV);
#pragma unroll
                for (int j = 0; j < 4; ++j) { const f32x4 y = {bflo(yw[i][j].x), bfhi(yw[i][j].x), bflo(yw[i][j].y), bfhi(yw[i][j].y)};
                    v[i][j] = v[i][j] + gt[j] * (y * rstd * gp[j]); __builtin_nontemporal_store(v[i][j], (f32x4*)(xo0 + (size_t)i * 1024 + 4 * lane + 256 * j)); } }
        }
        if (WRITE_H) {
            float ss[NR];
#pragma unroll
            for (int i = 0; i < NR; ++i) { ss[i] = 0.f;
#pragma unroll
                for (int j = 0; j < 4; ++j) ss[i] += (v[i][j].x * v[i][j].x + v[i][j].y * v[i][j].y) + (v[i][j].z * v[i][j].z + v[i][j].w * v[i][j].w); }
#pragma unroll
            for (int o = 1; o < 64; o <<= 1) {
#pragma unroll
                for (int i = 0; i < NR; ++i) ss[i] += __shfl_xor(ss[i], o); }
#pragma unroll
            for (int i = 0; i < NR; ++i) { const float rstd = rsqrtf(ss[i] * (1.f / 1024.f) + EPSV);
#pragma unroll
                for (int j = 0; j < 4; ++j) { const f32x4 hv = v[i][j] * rstd * gpre[j] * (1.f + s1[j]) + s0[j];
                    u32x2 w; w.x = pkbf(hv.x, hv.y); w.y = pkbf(hv.z, hv.w);
                    *(u32x2*)(H + (size_t)(r0 + i) * 1024 + 4 * lane + 256 * j) = w; } }
        }
    }
}
#ifndef STEP_MASK
#define STEP_MASK 0xFF
#endif
#define STEPON(i) (((STEP_MASK) >> (i)) & 1)
DI void conv_silu16(const u32x4* raw, const float* cw, float* out) {
#pragma unroll
    for (int hb = 0; hb < 2; ++hb) {
        float xc[8], xp[8], xn[8]; unpack8(raw[2 + hb], xc); unpack8(raw[hb], xp); unpack8(raw[4 + hb], xn);
        const f32x4 w0a = *(const f32x4*)(cw + 8 * hb), w0b = *(const f32x4*)(cw + 8 * hb + 4);
        const f32x4 w1a = *(const f32x4*)(cw + 1536 + 8 * hb), w1b = *(const f32x4*)(cw + 1536 + 8 * hb + 4);
        const f32x4 w2a = *(const f32x4*)(cw + 3072 + 8 * hb), w2b = *(const f32x4*)(cw + 3072 + 8 * hb + 4);
#pragma unroll
        for (int e = 0; e < 8; ++e) { const float w0 = e < 4 ? w0a[e & 3] : w0b[e & 3], w1 = e < 4 ? w1a[e & 3] : w1b[e & 3], w2 = e < 4 ? w2a[e & 3] : w2b[e & 3];
            out[8 * hb + e] = fsilu(w0 * xp[e] + w1 * xc[e] + w2 * xn[e]); }
    }
}
DI void load_rows16(const bf16_t* pp, bool hasp, bool hasn, u32x4* raw) {
    const u32x4 zero = {0u, 0u, 0u, 0u};
    raw[0] = hasp ? *(const u32x4*)(pp - 1536) : zero; raw[1] = hasp ? *(const u32x4*)(pp - 1536 + 8) : zero;
    raw[2] = *(const u32x4*)pp; raw[3] = *(const u32x4*)(pp + 8);
    raw[4] = hasn ? *(const u32x4*)(pp + 1536) : zero; raw[5] = hasn ? *(const u32x4*)(pp + 1536 + 8) : zero;
}

DI void phase_gdn_pre(const Params& p, int l, unsigned char* lds) {
    bf16_t* qL = (bf16_t*)lds;
    bf16_t* kL = qL + 64 * 136;
    bf16_t* kT = kL + 64 * 136;
    bf16_t* vT = kT + 128 * 72;
    float*  LF = (float*)(vT + 128 * 72);
    float*  LB = LF + 4096;
    bf16_t* TU = (bf16_t*)(LB + 4096);
    bf16_t* TW = TU + 2 * 64 * 72;
    float*  gv = (float*)(TW + 2 * 64 * 72);
    const bf16_t* PQ = (const bf16_t*)(p.ws + WS_PQ);
    const float* AB = (const float*)(p.ws + WS_AB);
    const float* cwq = p.conv_qkv + (size_t)l * 3 * 1536;
#define GDN_LOAD_UNIT(unx, tidx) do { const int cid_ = (unx) >> 2, h_ = (unx) & 3, c_ = (tidx) >> 3, cgp_ = (tidx) & 7, row_ = cid_ * 64 + c_; \
        const int pos_ = (cid_ < 32) ? ((cid_ & 3) * 64 + c_) : (((cid_ - 32) & 63) * 64 + c_); const int slen_ = (cid_ < 32) ? CTXL : SEQL; \
        const bool hasp_ = pos_ > 0, hasn_ = pos_ < slen_ - 1; const bf16_t* prow_ = PQ + (size_t)row_ * 1536 + h_ * 128 + cgp_ * 16; \
        load_rows16(prow_, hasp_, hasn_, rawq); load_rows16(prow_ + 512, hasp_, hasn_, rawk); load_rows16(prow_ + 1024, hasp_, hasn_, rawv); } while (0)
    for (int un = opaque_bid(); un < NUNITS; un += gridDim.x) {
        const int tid = opaque_tid();
        const int lane = tid & 63, wave = __builtin_amdgcn_readfirstlane(tid >> 6), r = lane & 31, hh = lane >> 5;
        const int cid = un >> 2, h = un & 3;
        unsigned char* GU = p.ws + WS_G + (size_t)un * UNIT_BYTES;
        u32x4 rawq[6], rawk[6], rawv[6];
        GDN_LOAD_UNIT(un, tid);
        float ab0 = 0.f, ab1 = 0.f, ab2 = 0.f, ab3 = 0.f;
        if (wave == 0) { const float* ab = AB + (size_t)(cid * 64 + lane) * 16; ab0 = ab[h]; ab1 = ab[4 + h]; ab2 = ab[8 + h]; ab3 = ab[12 + h]; }
        if (STEPON(0)) {
            const int c = tid >> 3, cgp = tid & 7;
            const float* cw = cwq + h * 128 + cgp * 16;
            float t[16];
            conv_silu16(rawq, cw, t);
            { float ss = 0.f;
#pragma unroll
              for (int e = 0; e < 16; ++e) ss += t[e] * t[e];
              ss += __shfl_xor(ss, 1); ss += __shfl_xor(ss, 2); ss += __shfl_xor(ss, 4);
              const float sc = rsqrtf(ss + EPSV) * 0.08838834764831845f;
#pragma unroll
              for (int e = 0; e < 16; ++e) t[e] *= sc; }
            { const u32x4 w0 = packw8(t), w1 = packw8(t + 8);
              *(u32x4*)(qL + c * 136 + cgp * 16) = w0; *(u32x4*)(qL + c * 136 + cgp * 16 + 8) = w1;
              const int frag = ((c >> 5) * 4 + (cgp >> 1)) * 2 + (cgp & 1);
              u32x4 f0, f1; f0.x = w0.x; f0.y = w0.y; f0.z = w1.x; f0.w = w1.y; f1.x = w0.z; f1.y = w0.w; f1.z = w1.z; f1.w = w1.w;
              u32x4* gq = (u32x4*)(GU + OFF_Q + frag * 1024);
              gq[c & 31] = f0; gq[32 + (c & 31)] = f1; }
            conv_silu16(rawk, cw + 512, t);
            { float ss = 0.f;
#pragma unroll
              for (int e = 0; e < 16; ++e) ss += t[e] * t[e];
              ss += __shfl_xor(ss, 1); ss += __shfl_xor(ss, 2); ss += __shfl_xor(ss, 4);
              const float sc = rsqrtf(ss + EPSV);
#pragma unroll
              for (int e = 0; e < 16; ++e) t[e] *= sc; }
            { *(u32x4*)(kL + c * 136 + cgp * 16) = packw8(t); *(u32x4*)(kL + c * 136 + cgp * 16 + 8) = packw8(t + 8);
#pragma unroll
              for (int e = 0; e < 16; ++e) kT[(cgp * 16 + e) * 72 + (c ^ (8 * cgp))] = bf1(t[e]); }
            conv_silu16(rawv, cw + 1024, t);
#pragma unroll
            for (int e = 0; e < 16; ++e) vT[(cgp * 16 + e) * 72 + (c ^ (8 * cgp))] = bf1(t[e]);
        }
        if (STEPON(1) && wave == 0) {
            const float bf_ = sigmf(ab0), bb_ = sigmf(ab1);
            float gf_ = -expf(p.a_log[l * 8 + h]) * softplusf(ab2 + p.dt_bias[l * 8 + h]);
            float gb_ = -expf(p.a_log[l * 8 + 4 + h]) * softplusf(ab3 + p.dt_bias[l * 8 + 4 + h]);
#pragma unroll
            for (int o = 1; o < 64; o <<= 1) { const float t1 = __shfl_up(gf_, o); if (lane >= o) gf_ += t1; const float t2 = __shfl_down(gb_, o); if (lane + o < 64) gb_ += t2; }
            gv[lane] = gf_; gv[64 + lane] = gb_; gv[128 + lane] = bf_; gv[192 + lane] = bb_;
            const float gfl = __shfl(gf_, 63), gbl = __shfl(gb_, 0);
            float* sc = (float*)(GU + OFF_SC);
            sc[lane] = expf(gf_); sc[64 + lane] = expf(gfl - gf_); if (lane < 4) sc[128 + lane] = expf(gfl);
            sc[132 + lane] = expf(gb_); sc[196 + lane] = expf(gbl - gb_); if (lane < 4) sc[260 + lane] = expf(gbl);
        }
        LBAR();
        if (STEPON(2)) {
            const int kind = wave >> 2, ti = (wave >> 1) & 1, tj = wave & 1;
            const bf16_t* Ab = kL + (32 * ti + r) * 136 + 8 * hh;
            const bf16_t* Bb = (kind ? qL : kL) + (32 * tj + r) * 136 + 8 * hh;
            f32x16 z;
#pragma unroll
            for (int i = 0; i < 16; ++i) z[i] = 0.f;
#pragma unroll
            for (int ks = 0; ks < 8; ++ks) z = MFMA32(*(const bf16x8*)(Ab + 16 * ks), *(const bf16x8*)(Bb + 16 * ks), z);
            const int cj = 32 * tj + r;
            const float gFj = gv[cj], gBj = gv[64 + cj];
            if (kind == 0) {
#pragma unroll
                for (int i = 0; i < 16; ++i) { const int ci = 32 * ti + crow(i, hh);
                    const float gFi = gv[ci], gBi = gv[64 + ci];
                    LF[ci * 64 + cj] = ci > cj ? z[i] * __expf(fminf(gFi - gFj, 0.f)) * gv[128 + ci] : 0.f;
                    LB[(63 - ci) * 64 + (63 - cj)] = ci < cj ? z[i] * __expf(fminf(gBi - gBj, 0.f)) * gv[192 + ci] : 0.f; }
            } else {
                f32x16 vf, vb;
#pragma unroll
                for (int i = 0; i < 16; ++i) { const int cp = 32 * ti + crow(i, hh);
                    vf[i] = cj >= cp ? z[i] * __expf(fminf(gFj - gv[cp], 0.f)) : 0.f;
                    vb[i] = cj <= cp ? z[i] * __expf(fminf(gBj - gv[64 + cp], 0.f)) : 0.f; }
#pragma unroll
                for (int s = 0; s < 2; ++s) {
                    *(bf16x8*)(GU + OFF_D0 + OFF_QK + ((tj * 2 + ti) * 2 + s) * 1024 + lane * 16) = pack16s(vf, s);
                    *(bf16x8*)(GU + OFF_D0 + DIR_BYTES + OFF_QK + ((tj * 2 + ti) * 2 + s) * 1024 + lane * 16) = pack16s(vb, s); }
            }
        }
        LBAR();
        if (STEPON(3) && wave < 2) {
            unsigned la = (unsigned)(size_t)(PG8_LAS float*)LF + (wave ? 16384u : 0u); asm volatile("" : "+v"(la));
            const PG8_LAS float* L = (const PG8_LAS float*)la;
            f32x2 T2[32];
#define TT(m) (T2[(m) >> 1][(m) & 1])
            f32x4 lcur[16], lnxt[16];
#pragma unroll
            for (int m4 = 0; m4 < 16; ++m4) { lcur[m4] = (f32x4){0.f, 0.f, 0.f, 0.f}; lnxt[m4] = lcur[m4]; }
#pragma unroll
            for (int k = 0; k < 32; ++k) T2[k] = (f32x2){0.f, 0.f};
            lcur[0] = *(const PG8_LAS f32x4*)(L + 64);
            T2[0][0] = (lane == 0) ? 1.f : 0.f;
#pragma unroll
            for (int i = 1; i < 64; ++i) {
                if (i + 1 < 64) {
#pragma unroll
                    for (int m4 = 0; m4 < (i + 4) / 4; ++m4) lnxt[m4] = *(const PG8_LAS f32x4*)(L + (i + 1) * 64 + 4 * m4);
                }
                __builtin_amdgcn_sched_barrier(0);
                f32x2 a0 = {(lane == i) ? 1.f : 0.f, 0.f}, a1 = {0.f, 0.f};
#pragma unroll
                for (int k = 0; k < i / 2; ++k) {
                    const f32x2 l2 = (k & 1) ? (f32x2){lcur[k >> 1][2], lcur[k >> 1][3]} : (f32x2){lcur[k >> 1][0], lcur[k >> 1][1]};
                    if (k & 1) a1 -= l2 * T2[k]; else a0 -= l2 * T2[k]; }
                float rsum = (a0[0] + a0[1]) + (a1[0] + a1[1]);
                if (i & 1) rsum -= lcur[(i - 1) >> 2][(i - 1) & 3] * TT(i - 1);
                TT(i) = rsum;
                __builtin_amdgcn_sched_barrier(0);
#pragma unroll
                for (int m4 = 0; m4 < (i + 4) / 4; ++m4) lcur[m4] = lnxt[m4];
            }
            const int cj = wave ? 63 - lane : lane;
            const float bj = gv[(wave ? 192 : 128) + cj], ej = expf(gv[(wave ? 64 : 0) + cj]);
            unsigned tu = (unsigned)(size_t)(PG8_LAS bf16_t*)TU + (wave ? (4608u + (unsigned)cj) * 2u : (unsigned)cj * 2u); asm volatile("" : "+v"(tu));
            PG8_LAS bf16_t* TUp = (PG8_LAS bf16_t*)tu; PG8_LAS bf16_t* TWp = TUp + 2 * 64 * 72;
            if (wave == 0) {
#pragma unroll
                for (int i = 0; i < 64; ++i) { TUp[i * 72] = bf1(TT(i) * bj); TWp[i * 72] = bf1(TT(i) * bj * ej); }
            } else {
#pragma unroll
                for (int i = 0; i < 64; ++i) { TUp[(63 - i) * 72] = bf1(TT(i) * bj); TWp[(63 - i) * 72] = bf1(TT(i) * bj * ej); }
            }
        }
        LBAR();
#pragma unroll
        for (int q4 = 0; q4 < (STEPON(4) ? 4 : 0); ++q4) {
            const int d = q4 >> 1, kind = q4 & 1;
            f32x16 z;
#pragma unroll
            for (int i = 0; i < 16; ++i) z[i] = 0.f;
            if (kind == 0) {
                const int tM = wave >> 1, tN = wave & 1;
                const int swz = 8 * (((32 * tM + r) >> 4) & 7);
                const bf16_t* Ab = kT + (32 * tM + r) * 72;
                const bf16_t* Bb = TW + d * 4608 + (32 * tN + r) * 72 + 8 * hh;
#pragma unroll
                for (int ks = 0; ks < 4; ++ks) z = MFMA32(*(const bf16x8*)(Ab + ((8 * hh + 16 * ks) ^ swz)), *(const bf16x8*)(Bb + 16 * ks), z);
#pragma unroll
                for (int s = 0; s < 2; ++s) *(bf16x8*)(GU + OFF_D0 + d * DIR_BYTES + OFF_W + ((tN * 4 + tM) * 2 + s) * 1024 + lane * 16) = pack16s(z, s);
            } else {
                const int tM = wave >> 2, tN = wave & 3;
                const bf16_t* Ab = TU + d * 4608 + (32 * tM + r) * 72 + 8 * hh;
                const int swz = 8 * (((32 * tN + r) >> 4) & 7);
                const bf16_t* Bb = vT + (32 * tN + r) * 72;
#pragma unroll
                for (int ks = 0; ks < 4; ++ks) z = MFMA32(*(const bf16x8*)(Ab + 16 * ks), *(const bf16x8*)(Bb + ((8 * hh + 16 * ks) ^ swz)), z);
                bf16x8* gu = (bf16x8*)(GU + OFF_D0 + d * DIR_BYTES + OFF_U + ((tN * 2 + tM) * 64 + lane) * 32);
                gu[0] = pack16s(z, 0); gu[1] = pack16s(z, 1);
            }
        }
#pragma unroll
        for (int f2 = 0; f2 < 2; ++f2) { const int fl = tid + 512 * f2, f = fl >> 6, ln = fl & 63, r2 = ln & 31, h2 = ln >> 5, mt = f >> 2, kt = (f >> 1) & 1, s = f & 1;
            const int swz = 8 * (((32 * mt + r2) >> 4) & 7), c0 = 32 * kt + 16 * s + 4 * h2;
            const bf16_t* src = kT + (32 * mt + r2) * 72;
            const u32x2 lo = *(const u32x2*)(src + (c0 ^ swz)), hi = *(const u32x2*)(src + ((c0 + 8) ^ swz));
            u32x4 o; o.x = lo.x; o.y = lo.y; o.z = hi.x; o.w = hi.y;
            *(u32x4*)(GU + OFF_KT + f * 1024 + ln * 16) = o; }
        LBAR();
    }
}

DI int scan_cid(int b, int d, int st) { return st < 4 ? (b * 4 + (d ? 3 - st : st)) : (32 + b * 64 + (d ? 67 - st : st - 4)); }
DI void phase_scan(const Params& p, int l, unsigned char* lds) {
    const int bid = opaque_bid();
    if (bid >= 64) return;
    const int b = bid >> 3, h = (bid >> 1) & 3, d = bid & 1;
    const unsigned char* G = p.ws + WS_G;
    bf16_t* OD = (bf16_t*)(p.ws + (d ? WS_OB : WS_OF));
    const int tid0 = opaque_tid();
    if (__builtin_amdgcn_readfirstlane(tid0 >> 6) >= 4) {
        const int lt = tid0 - 256;
#define SCAN_SRC(U, o) ((o) < 32768 ? (U) + (o) : (U) + OFF_D0 + d * DIR_BYTES + ((o) - 32768))
#define SCAN_LD(set, sets, step) do { const unsigned char* U_ = G + (size_t)(scan_cid(b, d, (step)) * 4 + h) * UNIT_BYTES; \
        _Pragma("unroll") for (int i_ = 0; i_ < 18; ++i_) { const int o_ = (lt + 256 * i_) * 16; set[i_] = *(const u32x4*)SCAN_SRC(U_, o_); } \
        if (lt < 33) sets = *(const u32x4*)(U_ + OFF_SC + d * SC_BYTES + lt * 16); } while (0)
#define SCAN_ST(set, sets, step) do { unsigned char* dst_ = lds + ((step) & 1) * SCAN_BUF; \
        _Pragma("unroll") for (int i_ = 0; i_ < 18; ++i_) *(u32x4*)(dst_ + (lt + 256 * i_) * 16) = set[i_]; \
        if (lt < 33) *(u32x4*)(dst_ + 73728 + lt * 16) = sets; } while (0)
        u32x4 sA[18], sB[18]; u32x4 sAs = {0u, 0u, 0u, 0u}, sBs = sAs;
        SCAN_LD(sA, sAs, 0); SCAN_ST(sA, sAs, 0);
        SCAN_LD(sA, sAs, 1); SCAN_LD(sB, sBs, 2);
        LBAR();
        unsigned* prog = (unsigned*)(p.ws + WS_BAR + 14336) + bid * 8;
        for (int st = 0; st < 68; st += 2) {
            SCAN_ST(sA, sAs, st + 1);
            if (st + 3 < 68) SCAN_LD(sA, sAs, st + 3);
            LBAR();
            if (lt == 0) __hip_atomic_store(prog, (unsigned)(l * 1000 + st + 1), __ATOMIC_RELAXED, __HIP_MEMORY_SCOPE_AGENT);
            if (st + 2 < 68) SCAN_ST(sB, sBs, st + 2);
            if (st + 4 < 68) SCAN_LD(sB, sBs, st + 4);
            LBAR();
            if (lt == 0) __hip_atomic_store(prog, (unsigned)(l * 1000 + st + 2), __ATOMIC_RELAXED, __HIP_MEMORY_SCOPE_AGENT);
        }
        return;
    }
    LBAR();
    f32x16 S[4];
#pragma unroll
    for (int k = 0; k < 4; ++k)
#pragma unroll
        for (int i = 0; i < 16; ++i) S[k][i] = 0.f;
    for (int st = 0; st < 68; ++st) {
        const int cur = st & 1;
        const int cid = scan_cid(b, d, st);
        int tidv = threadIdx.x; asm volatile("" : "+v"(tidv));
        const int lane = tidv & 63, wave = __builtin_amdgcn_readfirstlane(tidv >> 6), r = lane & 31, hh = lane >> 5;
        {
            const unsigned char* B0 = lds + cur * SCAN_BUF;
            const bf16x8* Aq = (const bf16x8*)(B0) + lane;
            const bf16x8* AkT = (const bf16x8*)(B0 + 16384) + lane;
            const bf16x8* Aw = (const bf16x8*)(B0 + 32768) + lane;
            const bf16x8* Aqk = (const bf16x8*)(B0 + 49152) + lane;
            const float* scl = (const float*)(B0 + 73728);
            const unsigned char* UU = B0 + 32768 + OFF_U;
            f32x16 ws[2], qs[2];
#pragma unroll
            for (int mt = 0; mt < 2; ++mt)
#pragma unroll
                for (int i = 0; i < 16; ++i) { ws[mt][i] = 0.f; qs[mt][i] = 0.f; }
#define SCAN_SB() __builtin_amdgcn_sched_barrier(0)
#define SCAN_LOADB(dst, kt) do { _Pragma("unroll") for (int s_ = 0; s_ < 2; ++s_) { const int f_ = (kt) * 2 + s_; dst[4 * s_ + 0] = Aw[f_ * 64]; dst[4 * s_ + 1] = Aw[(8 + f_) * 64]; dst[4 * s_ + 2] = Aq[f_ * 64]; dst[4 * s_ + 3] = Aq[(8 + f_) * 64]; } } while (0)
#define SCAN_MMAB(src, kt) do { _Pragma("unroll") for (int s_ = 0; s_ < 2; ++s_) { const bf16x8 sb_ = pack16s(S[kt], s_); ws[0] = MFMA32(src[4 * s_ + 0], sb_, ws[0]); ws[1] = MFMA32(src[4 * s_ + 1], sb_, ws[1]); qs[0] = MFMA32(src[4 * s_ + 2], sb_, qs[0]); qs[1] = MFMA32(src[4 * s_ + 3], sb_, qs[1]); } } while (0)
            bf16x8 fa[8], fb[8];
            SCAN_LOADB(fa, 0); SCAN_LOADB(fb, 1); SCAN_SB();
            SCAN_MMAB(fa, 0); SCAN_SB(); SCAN_LOADB(fa, 2); SCAN_SB();
            SCAN_MMAB(fb, 1); SCAN_SB(); SCAN_LOADB(fb, 3); SCAN_SB();
            SCAN_MMAB(fa, 2); SCAN_SB();
#pragma unroll
            for (int i = 0; i < 8; ++i) fa[i] = Aqk[i * 64];
            SCAN_SB();
            SCAN_MMAB(fb, 3); SCAN_SB();
            f32x16 vn[2];
#pragma unroll
            for (int mt = 0; mt < 2; ++mt) {
                const u32x4* up = (const u32x4*)(UU + ((wave * 2 + mt) * 64 + lane) * 32);
                const u32x4 u0 = up[0], u1 = up[1];
                f32x4 es[4];
#pragma unroll
                for (int g = 0; g < 4; ++g) es[g] = *(const f32x4*)(scl + 32 * mt + 8 * g + 4 * hh);
                float uf[16]; unpack8(u0, uf); unpack8(u1, uf + 8);
#pragma unroll
                for (int i = 0; i < 16; ++i) vn[mt][i] = uf[i] - ws[mt][i];
#pragma unroll
                for (int g = 0; g < 4; ++g)
#pragma unroll
                    for (int j = 0; j < 4; ++j) qs[mt][4 * g + j] *= es[g][j];
            }
            SCAN_SB();
#pragma unroll
            for (int i = 0; i < 8; ++i) fb[i] = AkT[i * 64];
            SCAN_SB();
            {
                bf16x8 vb[2][2];
#pragma unroll
                for (int kt = 0; kt < 2; ++kt)
#pragma unroll
                    for (int s = 0; s < 2; ++s) vb[kt][s] = pack16s(vn[kt], s);
#pragma unroll
                for (int kt = 0; kt < 2; ++kt)
#pragma unroll
                    for (int s = 0; s < 2; ++s) { qs[0] = MFMA32(fa[(0 * 2 + kt) * 2 + s], vb[kt][s], qs[0]); qs[1] = MFMA32(fa[(1 * 2 + kt) * 2 + s], vb[kt][s], qs[1]); }
            }
            SCAN_SB();
#pragma unroll
            for (int i = 0; i < 8; ++i) fa[i] = AkT[(8 + i) * 64];
            f32x4 et[2][4];
#pragma unroll
            for (int mt = 0; mt < 2; ++mt)
#pragma unroll
                for (int g = 0; g < 4; ++g) et[mt][g] = *(const f32x4*)(scl + 64 + 32 * mt + 8 * g + 4 * hh);
            const float decay = scl[128];
            SCAN_SB();
            {
                bf16x8 vt[2][2];
#pragma unroll
                for (int mt = 0; mt < 2; ++mt) {
#pragma unroll
                    for (int g = 0; g < 4; ++g)
#pragma unroll
                        for (int j = 0; j < 4; ++j) vn[mt][4 * g + j] *= et[mt][g][j];
                    vt[mt][0] = pack16s(vn[mt], 0); vt[mt][1] = pack16s(vn[mt], 1);
                }
#pragma unroll
                for (int mt = 0; mt < 4; ++mt) {
#pragma unroll
                    for (int i = 0; i < 16; ++i) S[mt][i] *= decay;
#pragma unroll
                    for (int kt = 0; kt < 2; ++kt)
#pragma unroll
                        for (int s = 0; s < 2; ++s) S[mt] = MFMA32((mt < 2 ? fb : fa)[((mt & 1) * 2 + kt) * 2 + s], vt[kt][s], S[mt]);
                }
            }
            if (l == 0 || cid >= 32) {
#pragma unroll
                for (int mt = 0; mt < 2; ++mt)
#pragma unroll
                    for (int i = 0; i < 16; ++i) __builtin_nontemporal_store(bf1(qs[mt][i]), &OD[(size_t)(cid * 64 + 32 * mt + crow(i, hh)) * 512 + h * 128 + 32 * wave + r]);
            }
        }
        LBAR();
    }
}

DI void scan_helper(const Params& p, int l, int s) {
    const int b = s >> 3, h = (s >> 1) & 3, d = s & 1;
    const unsigned char* G = p.ws + WS_G;
    unsigned* prog = (unsigned*)(p.ws + WS_BAR + 14336) + s * 8;
    constexpr int LEAD = 5;
    unsigned acc = 0u;
    for (int st = 4; st < 68; ++st) {
        const int tid = opaque_tid();
        if (tid == 0) { const int want = l * 1000 + st - LEAD; while ((int)__hip_atomic_load(prog, __ATOMIC_RELAXED, __HIP_MEMORY_SCOPE_AGENT) < want) __builtin_amdgcn_s_sleep(8); }
        LBAR();
        const unsigned char* U = G + (size_t)(scan_cid(b, d, st) * 4 + h) * UNIT_BYTES;
        for (int ln = tid; ln < 581; ln += 512) {
            const int off = ln < 256 ? ln * 128 : (ln < 576 ? OFF_D0 + d * DIR_BYTES + (ln - 256) * 128 : OFF_SC + d * SC_BYTES + (ln - 576) * 128);
            acc += *(const unsigned*)(U + off);
        }
    }
    if (acc == 0x9e3779b9u) prog[1] = acc;
}

template <int MODE> DI void phase_mix(const Params& p, int l, unsigned char* lds, int b0, int nb) {
    const bf16_t* PA = (const bf16_t*)(p.ws + WS_PA);
    const bf16_t* PZ = (const bf16_t*)(p.ws + WS_PZ);
    const bf16_t* OF = (const bf16_t*)(p.ws + WS_OF);
    const bf16_t* OB = (const bf16_t*)(p.ws + WS_OB);
    bf16_t* YM = (bf16_t*)(p.ws + WS_YMIX);
    bf16_t* YAC = (bf16_t*)(p.ws + WS_YAC);
    const int cu_lo = l ? 16 : 0, cid_lo = l ? 32 : 0;
    const int nC = MODE == 0 ? 272 - cu_lo : 0, nAB = 544 - cid_lo;
    for (int un = opaque_bid() - b0; un < nC + nAB; un += nb) {
        const int tid = opaque_tid(), lane = tid & 63, wave = __builtin_amdgcn_readfirstlane(tid >> 6), r = lane & 31, hh = lane >> 5;
        if (un < nC) {
            const int R0 = (cu_lo + un) * 128;
            bf16_t* vT = (bf16_t*)lds;
            {
                const int rr = tid >> 2, g = tid & 3, row = R0 + rr;
                const bf16_t* src = PZ + (size_t)row * 1024 + 768 + g * 64;
                float v[64];
#pragma unroll
                for (int i = 0; i < 8; ++i) unpack8(*(const u32x4*)(src + 8 * i), v + 8 * i);
                float sum = 0.f;
#pragma unroll
                for (int e = 0; e < 64; ++e) { v[e] = fgelu(v[e]); sum += v[e]; }
                sum += __shfl_xor(sum, 1); sum += __shfl_xor(sum, 2);
                const float mu = sum * (1.f / 256.f);
                float var = 0.f;
#pragma unroll
                for (int e = 0; e < 64; ++e) { const float dlt = v[e] - mu; var += dlt * dlt; }
                var += __shfl_xor(var, 1); var += __shfl_xor(var, 2);
                const float rstd = rsqrtf(var * (1.f / 256.f) + EPSV);
                const float* lg = p.ln_c_g + l * 256 + g * 64; const float* lb = p.ln_c_b + l * 256 + g * 64;
#pragma unroll
                for (int e = 0; e < 64; ++e) vT[(g * 64 + e) * 136 + rr] = bf1((v[e] - mu) * rstd * lg[e] + lb[e]);
            }
            LBAR();
            {
                const int g2 = wave >> 1, ph = wave & 1;
                f32x16 acc[2][2];
#pragma unroll
                for (int a = 0; a < 2; ++a)
#pragma unroll
                    for (int bq = 0; bq < 2; ++bq)
#pragma unroll
                        for (int i = 0; i < 16; ++i) acc[a][bq][i] = 0.f;
                const float* Wg = p.w_s + (size_t)(l * 4 + g2) * 128 * 128;
#pragma unroll 2
                for (int ks = 0; ks < 8; ++ks) {
                    bf16x8 a[2], bb[2];
#pragma unroll
                    for (int mt = 0; mt < 2; ++mt) { const float* wp = Wg + (size_t)(64 * ph + 32 * mt + r) * 128 + 16 * ks + 8 * hh;
                        const f32x4 w0 = *(const f32x4*)wp, w1 = *(const f32x4*)(wp + 4);
                        u32x4 w; w.x = pkbf(w0.x, w0.y); w.y = pkbf(w0.z, w0.w); w.z = pkbf(w1.x, w1.y); w.w = pkbf(w1.z, w1.w); a[mt] = __builtin_bit_cast(bf16x8, w); }
#pragma unroll
                    for (int nt = 0; nt < 2; ++nt) bb[nt] = *(const bf16x8*)(vT + (g2 * 64 + 32 * nt + r) * 136 + 16 * ks + 8 * hh);
#pragma unroll
                    for (int mt = 0; mt < 2; ++mt)
#pragma unroll
                        for (int nt = 0; nt < 2; ++nt) acc[mt][nt] = MFMA32(a[mt], bb[nt], acc[mt][nt]);
                }
                const float* bs = p.b_s + (size_t)(l * 4 + g2) * 128;
                bf16_t cuw[2][2][16];
#pragma unroll
                for (int mt = 0; mt < 2; ++mt)
#pragma unroll
                    for (int nt = 0; nt < 2; ++nt)
#pragma unroll
                        for (int i = 0; i < 16; ++i) { const int prow = 64 * ph + 32 * mt + crow(i, hh), row = R0 + prow, ch = g2 * 64 + 32 * nt + r;
                            cuw[mt][nt][i] = PZ[(size_t)row * 1024 + 512 + ch]; }
#pragma unroll
                for (int mt = 0; mt < 2; ++mt)
#pragma unroll
                    for (int nt = 0; nt < 2; ++nt)
#pragma unroll
                        for (int i = 0; i < 16; ++i) { const int prow = 64 * ph + 32 * mt + crow(i, hh), row = R0 + prow, ch = g2 * 64 + 32 * nt + r;
                            YAC[(size_t)row * 512 + 256 + ch] = bf1(fgelu(bf2f(cuw[mt][nt][i])) * (acc[mt][nt][i] + bs[prow])); }
            }
            LBAR();
        } else {
            const int cid = cid_lo + (un - nC);
            const int c = tid >> 3, sub = tid & 7, row = cid * 64 + c;
            const bool isctx = cid < 32;
            const int pos = isctx ? ((cid & 3) * 64 + c) : (((cid - 32) & 63) * 64 + c);
            {
                const bool vert = (!isctx) && (sub >= 4);
                const int dstep = vert ? 64 : 1;
                bool hasp, hasn;
                if (isctx) { hasp = pos > 0; hasn = pos < CTXL - 1; }
                else if (!vert) { const int col = pos & 63; hasp = col > 0; hasn = col < 63; }
                else { hasp = pos >= 64; hasn = pos < SEQL - 64; }
                const u32x4 zero = {0u, 0u, 0u, 0u};
                if (MODE == 0) {
                const bf16_t* pa = PA + (size_t)row * 768 + sub * 32;
#pragma unroll 1
                for (int hb2 = 0; hb2 < 4; hb2 += 2) {
                    u32x4 rab[2], rcc[2], rch[2], rpc[2], rph[2], rnc[2], rnh[2];
#pragma unroll
                    for (int q = 0; q < 2; ++q) { const int hb = hb2 + q;
                        rab[q] = *(const u32x4*)(pa + hb * 8); rcc[q] = *(const u32x4*)(pa + 256 + hb * 8); rch[q] = *(const u32x4*)(pa + 512 + hb * 8);
                        rpc[q] = hasp ? *(const u32x4*)(pa - (size_t)dstep * 768 + 256 + hb * 8) : zero; rph[q] = hasp ? *(const u32x4*)(pa - (size_t)dstep * 768 + 512 + hb * 8) : zero;
                        rnc[q] = hasn ? *(const u32x4*)(pa + (size_t)dstep * 768 + 256 + hb * 8) : zero; rnh[q] = hasn ? *(const u32x4*)(pa + (size_t)dstep * 768 + 512 + hb * 8) : zero; }
#pragma unroll
                    for (int q = 0; q < 2; ++q) { const int hb = hb2 + q;
                        const float* cw = p.conv_a + (size_t)l * 768 + sub * 32 + hb * 8;
                        float ab_[8], cc[8], ch_[8], pc[8], ph_[8], nc[8], nh[8];
                        unpack8(rab[q], ab_); unpack8(rcc[q], cc); unpack8(rch[q], ch_); unpack8(rpc[q], pc); unpack8(rph[q], ph_); unpack8(rnc[q], nc); unpack8(rnh[q], nh);
                        float o[8];
#pragma unroll
                        for (int e = 0; e < 8; ++e) o[e] = ab_[e] * (cw[e] * (pc[e] * ph_[e]) + cw[256 + e] * (cc[e] * ch_[e]) + cw[512 + e] * (nc[e] * nh[e]));
                        *(u32x4*)(YAC + (size_t)row * 512 + sub * 32 + hb * 8) = packw8(o); }
                }
                } else {
                const int head = sub >> 1, hf = sub & 1;
                const size_t ob = (size_t)row * 512 + head * 128 + hf * 64;
                const bf16_t* zp = PZ + (size_t)row * 1024 + head * 128 + hf * 64;
                u32x4 rof[8], rob[8], rz[8], rcp[8];
#pragma unroll
                for (int i = 0; i < 8; ++i) { rof[i] = *(const u32x4*)(OF + ob + 8 * i); rob[i] = *(const u32x4*)(OB + ob + 8 * i); rz[i] = *(const u32x4*)(zp + 8 * i);
                    rcp[i] = *(const u32x4*)(YAC + (size_t)row * 512 + sub * 64 + 8 * i); }
                { bf16_t* cd = YM + (size_t)row * 1024 + (sub < 4 ? sub * 64 : 768 + (sub - 4) * 64);
#pragma unroll
                  for (int i = 0; i < 8; ++i) *(u32x4*)(cd + 8 * i) = rcp[i]; }
                float ss = 0.f;
#pragma unroll
                for (int i = 0; i < 8; ++i) { float a[8], bq[8]; unpack8(rof[i], a); unpack8(rob[i], bq);
#pragma unroll
                    for (int e = 0; e < 8; ++e) { const float o = a[e] + bq[e]; ss += o * o; } }
                ss += __shfl_xor(ss, 1);
                const float rstd = rsqrtf(ss * (1.f / 128.f) + EPSV);
                const float* gw = p.g_onorm + l * 128 + hf * 64;
                bf16_t* yo = YM + (size_t)row * 1024 + 256 + head * 128 + hf * 64;
#pragma unroll
                for (int i = 0; i < 8; ++i) { float a[8], bq[8], zz[8], o[8]; unpack8(rof[i], a); unpack8(rob[i], bq); unpack8(rz[i], zz);
#pragma unroll
                    for (int e = 0; e < 8; ++e) o[e] = (a[e] + bq[e]) * rstd * gw[8 * i + e] * fsilu(zz[e]);
                    *(u32x4*)(yo + 8 * i) = packw8(o); }
                }
            }
        }
    }
}


#define LAS __attribute__((address_space(3)))
#define XB_TMO      128
#define XB_XCNT(j)  (256  + 64 * (j))
#define XB_XSUB(j)  (1280 + 64 * (j))
#define XB_XGEN(j)  (2304 + 64 * (j))
#define XB_TOP      3328
#define XB_TOPGEN   3392
#define XCD_BAR_WORDS 3456
#define XB_SPIN_CAP (1u << 18)

__device__ __forceinline__ unsigned xb_ld(unsigned* p)              { return __hip_atomic_load(p, __ATOMIC_RELAXED, __HIP_MEMORY_SCOPE_AGENT); }
__device__ __forceinline__ unsigned xb_add(unsigned* p, unsigned v) { return __hip_atomic_fetch_add(p, v, __ATOMIC_RELAXED, __HIP_MEMORY_SCOPE_AGENT); }
__device__ __forceinline__ unsigned xb_xcc_id() { return (unsigned)__builtin_amdgcn_s_getreg((3 << 11) | 20) & 0xFu; }
#define XB_SPIN(cond, bar) do { unsigned _sp = 0; while (cond) { __builtin_amdgcn_s_sleep(1); \
    if ((++_sp & 255u) == 0u) { if (xb_ld(&(bar)[XB_TMO])) break; if (_sp > XB_SPIN_CAP) { atomicAdd(&(bar)[XB_TMO], 1u); break; } } } } while (0)

struct XcdBarrier {
    unsigned* bar; unsigned x;
    volatile LAS unsigned* st;
};

__device__ __forceinline__ XcdBarrier xcd_barrier_post(unsigned* bar, volatile LAS unsigned* st) {
    XcdBarrier b; b.bar = bar; b.x = xb_xcc_id(); b.st = st;
    if (threadIdx.x == 0) (void)xb_add(&bar[XB_XCNT(b.x)], 1u);
    return b;
}
__device__ __forceinline__ void xcd_barrier_complete(unsigned* bar, unsigned x, unsigned& nloc, unsigned& nx) {
    const unsigned G = gridDim.x * gridDim.y * gridDim.z;
    unsigned sum, cnt, mine, sp = 0u;
    for (;;) {
        sum = 0u; cnt = 0u; mine = 0u;
#pragma unroll
        for (unsigned j = 0; j < 16; ++j) { const unsigned c = xb_ld(&bar[XB_XCNT(j)]); sum += c; cnt += (c > 0u) ? 1u : 0u; mine = (j == x) ? c : mine; }
        if (sum == G) break;
        __builtin_amdgcn_s_sleep(1);
        if ((++sp & 255u) == 0u) { if (xb_ld(&bar[XB_TMO])) break; if (sp > XB_SPIN_CAP) { atomicAdd(&bar[XB_TMO], 1u); break; } }
    }
    nloc = mine > 0u ? mine : 1u; nx = cnt > 0u ? cnt : 1u;
}

__device__ __forceinline__ void xcd_barrier(const XcdBarrier& b) {
    asm volatile("s_waitcnt vmcnt(0)" ::: "memory");
    __syncthreads();
    if (threadIdx.x == 0) {
        unsigned* bar = b.bar;
        __builtin_amdgcn_s_waitcnt(0);
        unsigned nloc = b.st[0], nx = b.st[1];
        if (nloc == 0u) { xcd_barrier_complete(bar, b.x, nloc, nx); b.st[0] = nloc; b.st[1] = nx; }
        const unsigned old = xb_add(&bar[XB_XSUB(b.x)], 1u);
        const unsigned gen = old / nloc;
        if (old + 1u == (gen + 1u) * nloc) {
            __builtin_amdgcn_fence(__ATOMIC_RELEASE, "agent");
            asm volatile("s_waitcnt vmcnt(0)" ::: "memory");
            const unsigned og = xb_add(&bar[XB_TOP], 1u);
            const unsigned tg = og / nx;
            if (og + 1u == (tg + 1u) * nx) xb_add(&bar[XB_TOPGEN], 1u);
            else XB_SPIN(xb_ld(&bar[XB_TOPGEN]) == tg, bar);
            __builtin_amdgcn_fence(__ATOMIC_ACQUIRE, "agent");
            xb_add(&bar[XB_XGEN(b.x)], 1u);
            asm volatile("s_waitcnt vmcnt(0)" ::: "memory");
        } else {
            XB_SPIN(xb_ld(&bar[XB_XGEN(b.x)]) == gen, bar);
            __builtin_amdgcn_fence(__ATOMIC_ACQUIRE, "agent");
            asm volatile("s_waitcnt vmcnt(0)" ::: "memory");
        }
    }
    __syncthreads();
}

constexpr int NPHASES = 20;
#ifndef PH_MASK
#define PH_MASK 0xFFFF
#endif
#define PHON(i) (((PH_MASK) >> (i)) & 1)
template <int PH> DI void run_phase(const Params& p, unsigned char* smem, PG8_LAS unsigned char* lds3, const int G) {
    const int bx = opaque_bid();
    float* MOD = (float*)(p.ws + WS_MOD); float* XC = (float*)(p.ws + WS_XC); bf16_t* H = (bf16_t*)(p.ws + WS_H);
    if constexpr (PH == 0) { phase_mod(p, smem); phase_convert<0>(p, 0, smem); }
    else if constexpr (PH == 1) { rowpass<0, true>(0, p.x, p.ctx, nullptr, nullptr, nullptr, nullptr, 0, nullptr, nullptr, p.g_pre_mix, MOD, 0, H); }
    else {
        constexpr int l = (PH - 2) / 9, k = (PH - 2) % 9;
        constexpr int rlo = l ? RC : 0;
        const float* xin_x = l ? p.out : p.x; const float* xin_c = l ? XC : p.ctx;
        const float* modl = MOD + (size_t)l * 9 * 6144;
        if constexpr (k == 0) {
            pg8::Gemm g{(const bf16_t*)H, (const bf16_t*)(p.ws + WS_WIN), RT, NIN, 1024, 1024}; pg8::StaticOrder S; S.init(RT, NIN, G, bx);
            EpiInProj E{(bf16_t*)(p.ws + WS_PA), (bf16_t*)(p.ws + WS_PQ), (bf16_t*)(p.ws + WS_PZ), (float*)(p.ws + WS_AB)};
            pg8::gemm_phase<EpiInProj, pg8::StaticOrder, false, true>(lds3, g, S, E);
        } else if constexpr (k == 1) { phase_gdn_pre(p, l, smem); }
        else if constexpr (k == 2) { if (bx < 64) phase_scan(p, l, smem); else if (G >= 256 && bx < 128) scan_helper(p, l, bx - 64); else if (G >= 256 && bx < 160) phase_convert<1>(p, l, smem, 128, 32); else { if (G < 256 && bx == 64) phase_convert<1>(p, l, smem, 64, 1); const int b0 = G >= 256 ? 160 : 64; phase_mix<0>(p, l, smem, b0, G - b0); } }
        else if constexpr (k == 3) { phase_mix<1>(p, l, smem, 0, G); }
        else if constexpr (k == 4) {
            {
                pg8::Gemm g{(const bf16_t*)(p.ws + WS_YMIX) + (size_t)RC * 1024, (const bf16_t*)(p.ws + WS_WO), RX, 1024, 1024, 1024}; pg8::StaticOrder S; S.init(RX, 1024, G, bx);
                EpiBf16Out E{(bf16_t*)(p.ws + WS_YO) + (size_t)RC * 1024, 1024};
                pg8::gemm_phase<EpiBf16Out, pg8::StaticOrder, false, true>(lds3, g, S, E); }
            if constexpr (l == 0) {
#pragma unroll 1
                for (int hk = 0; hk < 2; ++hk) {
                    pg8::Gemm g{(const bf16_t*)(p.ws + WS_YMIX) + hk * 512, (const bf16_t*)(p.ws + WS_WO) + hk * 512, RC, 1024, 512, 1024}; pg8::StaticOrder S; S.init(RC, 1024, G, (bx + G - 32 * hk) % G);
                    EpiBf16Out E{hk ? (bf16_t*)(p.ws + WS_CTXB) : (bf16_t*)(p.ws + WS_YO), 1024};
                    pg8::gemm_phase<EpiBf16Out, pg8::StaticOrder, false, true>(lds3, g, S, E); }
            }
        } else if constexpr (k == 5) {
            rowpass<1, true>(rlo, xin_x, xin_c, (const bf16_t*)(p.ws + WS_YO), l == 0 ? (const bf16_t*)(p.ws + WS_CTXB) : nullptr, p.g_post_mix + l * 1024, modl, 2, p.out, XC, p.g_pre_ffn + l * 1024, modl, 3, H);
        } else if constexpr (k == 6) {
            constexpr int M = RT - rlo;
            pg8::Gemm g{(const bf16_t*)H + (size_t)rlo * 1024, (const bf16_t*)(p.ws + WS_WF1), M, NF1, 1024, 1024}; pg8::StaticOrder S; S.init(M, NF1, G, bx);
            EpiSwiglu E{(bf16_t*)(p.ws + WS_HID) + (size_t)rlo * FH};
            pg8::gemm_phase<EpiSwiglu, pg8::StaticOrder, false, true>(lds3, g, S, E);
        } else if constexpr (k == 7) {
            {
                pg8::Gemm g{(const bf16_t*)(p.ws + WS_HID) + (size_t)RC * FH, (const bf16_t*)(p.ws + WS_WF2), RX, 1024, FH, FH}; pg8::StaticOrder S; S.init(RX, 1024, G, bx);
                EpiBf16Out E{(bf16_t*)(p.ws + WS_Y2) + (size_t)RC * 1024, 1024};
                pg8::gemm_phase<EpiBf16Out, pg8::StaticOrder, false, true>(lds3, g, S, E); }
            if constexpr (l == 0) {
#pragma unroll 1
                for (int hk = 0; hk < 2; ++hk) {
                    pg8::Gemm g{(const bf16_t*)(p.ws + WS_HID) + hk * (FH / 2), (const bf16_t*)(p.ws + WS_WF2) + hk * (FH / 2), RC, 1024, FH / 2, FH}; pg8::StaticOrder S; S.init(RC, 1024, G, (bx + G - 32 * hk) % G);
                    EpiBf16Out E{hk ? (bf16_t*)(p.ws + WS_CTXB) : (bf16_t*)(p.ws + WS_Y2), 1024};
                    pg8::gemm_phase<EpiBf16Out, pg8::StaticOrder, false, true>(lds3, g, S, E); }
            }
        } else {
            if constexpr (l == 0) { rowpass<1, true>(rlo, p.out, XC, (const bf16_t*)(p.ws + WS_Y2), (const bf16_t*)(p.ws + WS_CTXB), p.g_post_ffn, modl, 5, p.out, XC, p.g_pre_mix + 1024, MOD + (size_t)9 * 6144, 0, H); phase_convert<0>(p, 1, smem); }
            else rowpass<1, false>(rlo, p.out, XC, (const bf16_t*)(p.ws + WS_Y2), nullptr, p.g_post_ffn + 1024, modl, 5, p.out, XC, nullptr, nullptr, 0, nullptr);
        }
    }
}
template <int PH> DI void run_from(const Params& p, unsigned char* smem, PG8_LAS unsigned char* lds3, const int G, const XcdBarrier& xbar, cg::grid_group& grid) {
    run_phase<PH>(p, smem, lds3, G);
    if constexpr (PH + 1 < NPHASES) {
        if (PH == 0 && p.ph_lo < 0) grid.sync(); else xcd_barrier(xbar);
        run_from<PH + 1>(p, smem, lds3, G, xbar, grid);
    }
}
__global__ void __launch_bounds__(512) mega_fwd(Params p) {
    extern __shared__ __attribute__((aligned(16))) unsigned char smem[];
    cg::grid_group grid = cg::this_grid();
    volatile LAS unsigned* bst = (volatile LAS unsigned*)((LAS unsigned char*)smem + (LDS_BYTES - 64));
    if (threadIdx.x < 2) bst[threadIdx.x] = 0u;
    __syncthreads();
    const XcdBarrier xbar = xcd_barrier_post((unsigned*)(p.ws + WS_BAR), bst);
    run_from<0>(p, smem, (PG8_LAS unsigned char*)smem, (int)gridDim.x, xbar, grid);
}

extern "C" void kernel_launch(void* const* d_in, const int* in_sizes, int n_in, void* d_out, int out_size, void* d_ws, size_t ws_size, hipStream_t stream) {
    static int grid = 0;
    if (grid == 0) {
        if (n_in != 23 || ws_size < WS_END) { fprintf(stderr, "kernel_launch: unexpected inputs (n_in %d) or workspace too small (%zu < %zu)\n", n_in, ws_size, (size_t)WS_END); grid = -1; return; }
        int dev = 0, cus = 0, per_cu = 0;
        (void)hipGetDevice(&dev);
        (void)hipDeviceGetAttribute(&cus, hipDeviceAttributeMultiprocessorCount, dev);
        if (hipFuncSetAttribute((const void*)mega_fwd, hipFuncAttributeMaxDynamicSharedMemorySize, LDS_BYTES) != hipSuccess) { fprintf(stderr, "kernel_launch: hipFuncSetAttribute failed\n"); grid = -1; return; }
        if (hipOccupancyMaxActiveBlocksPerMultiprocessor(&per_cu, (const void*)mega_fwd, 512, LDS_BYTES) != hipSuccess || per_cu < 1) { per_cu = 1; (void)hipGetLastError(); }
        if (cus <= 0) cus = 256;
        grid = cus * per_cu;
    }
    if (grid < 0) return;
    Params p{};
    const float** pp = (const float**)&p;
    for (int i = 0; i < 23; ++i) pp[i] = (const float*)d_in[i];
    p.out = (float*)d_out; p.ws = (unsigned char*)d_ws; p.ph_lo = 0; p.ph_hi = NPHASES;
    (void)hipMemsetAsync((char*)d_ws + WS_BAR, 0, 16384, stream);
    void* args[] = {&p};
    hipError_t e = hipLaunchCooperativeKernel((const void*)mega_fwd, dim3(grid), dim3(512), args, LDS_BYTES, stream);
    if (e != hipSuccess) fprintf(stderr, "cooperative launch failed: %s (grid %d)\n", hipGetErrorString(e), grid);
}
```

```cpp
#include <hip/hip_runtime.h>
#include <hip/hip_cooperative_groups.h>
#include <cstdio>
#include <cstdint>
namespace cg = cooperative_groups;

__device__ __forceinline__ int opaque_tid() { int t = threadIdx.x; asm volatile("" : "+v"(t)); return t; }
__device__ __forceinline__ int opaque_bid() { int t = blockIdx.x; asm volatile("" : "+s"(t)); return t; }
namespace pg8 {
#define PG8_LAS __attribute__((address_space(3)))
typedef unsigned short bf16_t;
typedef short bf16x8 __attribute__((ext_vector_type(8)));
typedef float f32x4 __attribute__((ext_vector_type(4)));
typedef unsigned u32x4 __attribute__((ext_vector_type(4)));
constexpr int BM = 256, BK = 64, HALF = 128, HTB = HALF * BK * 2  , STAGE_BYTES = 8 * HTB, NXCD = 8, WGM = 8;

__host__ __device__ __forceinline__ int lds_byte(int r, int c) { const int st = (r >> 4) * 2 + (c >> 5), rr = r & 15, cc = c & 31, ob = rr * 64 + cc * 2; return st * 1024 + (ob ^ (((ob >> 9) & 1) << 5)); }
__host__ __device__ __forceinline__ void stage_rc(int b, int& R, int& C) { const int st = b / 1024, sb = b % 1024, swz = sb ^ (((sb >> 9) & 1) << 5); R = (st >> 1) * 16 + swz / 64; C = (st & 1) * 32 + (swz % 64) / 2; }
__host__ __device__ __forceinline__ int perm32(int rho) { const int n = rho >> 4, i = rho & 15; return 8 * (i >> 2) + 4 * n + (i & 3); }

struct Unit { int pm, pn; };
struct Gemm { const bf16_t* A; const bf16_t* Bt; int M, N, K, ld; };

struct StaticOrder {
    int nM, nN, nwg, G, c;
    __host__ __device__ void init(int M, int N, int G_, int c_) { nM = M / BM; nN = N / BM; nwg = nM * nN; G = G_; c = c_; }
    __host__ __device__ bool next(int i, Unit& u) const {
        const long L = (long)i * G + c; if (L >= nwg) return false;
        int wgid = (int)L; { const int q = nwg / NXCD, r = nwg % NXCD, xcd = wgid % NXCD, off = wgid / NXCD; wgid = (xcd < r ? xcd * (q + 1) : r * (q + 1) + (xcd - r) * q) + off; }
        const int nig = WGM * nN, gid = wgid / nig, fm = gid * WGM, gsz = (nM - fm) < WGM ? (nM - fm) : WGM;
        u.pm = fm + ((wgid % nig) % gsz); u.pn = (wgid % nig) / gsz; return true;
    }
    __device__ __forceinline__ void a_ready(const Unit&) const {}
    __device__ __forceinline__ void done(const Unit&) const {}
};

template <class Epi, class Sched, bool ALIGN_EPI = false, bool SP2 = false>
__device__ __forceinline__ void gemm_phase(PG8_LAS unsigned char* lds, const Gemm g, const Sched& S, const Epi& E) {
    const int tid = opaque_tid(), wid = __builtin_amdgcn_readfirstlane(tid >> 6), lane = tid & 63, wr = wid >> 2, wc = wid & 3, fr = lane & 15, fq = lane >> 4;
    const int K = g.ld, nt = g.K / BK;
    unsigned voffA[2], voffB[2];
#pragma unroll
    for (int i = 0; i < 2; ++i) { int R, C; stage_rc(tid * 16 + i * 8192, R, C); const int Rb = Epi::PERM ? ((R & ~31) + perm32(R & 31)) : R;
        voffA[i] = (unsigned)(R * K + C) * 2u; voffB[i] = (unsigned)(Rb * K + C) * 2u; }
    const size_t kstep = (size_t)(BK * 2);
    const size_t hstep = (size_t)HALF * K * 2;
    const size_t tstep = 2 * hstep;
    const unsigned ldsw = (unsigned)wid * 1024u;
    const int aoff = lds_byte(wr * 64 + fr, fq * 8), boff = lds_byte(wc * 32 + fr, fq * 8);
#define PG8_SA(b, h) (((b) * 2 + (h)) * HTB)
#define PG8_SB(b, h) ((4 + (b) * 2 + (h)) * HTB)
#define PG8_STAGE(bufoff, gbase, voff) do { _Pragma("unroll") for (int _i = 0; _i < 2; ++_i) \
        __builtin_amdgcn_global_load_lds((const unsigned*)((const char*)(gbase) + (voff)[_i]), (PG8_LAS unsigned*)(lds + (bufoff) + ldsw + _i * 8192), 16, 0, 0); } while (0)
#define PG8_LDA(dst, b, h) do { _Pragma("unroll") for (int m = 0; m < 4; ++m) _Pragma("unroll") for (int k = 0; k < 2; ++k) dst[m][k] = *(const PG8_LAS bf16x8*)(lds + PG8_SA(b, h) + aoff + m * 2048 + k * 1024); } while (0)
#define PG8_LDB(dst, b, h) do { _Pragma("unroll") for (int n = 0; n < 2; ++n) _Pragma("unroll") for (int k = 0; k < 2; ++k) dst[n][k] = *(const PG8_LAS bf16x8*)(lds + PG8_SB(b, h) + boff + n * 2048 + k * 1024); } while (0)
#define PG8_MMA(ai, bj, At, Bt) do { __builtin_amdgcn_s_setprio(1); _Pragma("unroll") for (int m = 0; m < 4; ++m) _Pragma("unroll") for (int n = 0; n < 2; ++n) _Pragma("unroll") for (int k = 0; k < 2; ++k) \
        acc[ai][bj][m][n] = __builtin_amdgcn_mfma_f32_16x16x32_bf16(Bt[n][k], At[m][k], acc[ai][bj][m][n], 0, 0, 0); __builtin_amdgcn_s_setprio(0); } while (0)
#define PG8_WAIT_V(n) asm volatile("s_waitcnt vmcnt(" #n ")" ::: "memory")
#define PG8_WAIT_L(n) asm volatile("s_waitcnt lgkmcnt(" #n ")" ::: "memory")
#define PG8_BAR __builtin_amdgcn_s_barrier()
#define PG8_SCHED __builtin_amdgcn_sched_barrier(0)
    Unit cur, nxt; int ui = 0;
    if (!S.next(0, cur)) return;
    f32x4 acc[2][2][4][2];
#pragma unroll
    for (int a = 0; a < 2; ++a)
#pragma unroll
        for (int b = 0; b < 2; ++b)
#pragma unroll
            for (int m = 0; m < 4; ++m)
#pragma unroll
                for (int n = 0; n < 2; ++n) acc[a][b][m][n] = (f32x4){0.f, 0.f, 0.f, 0.f};
    bf16x8 At[4][2], B0[2][2], B1[2][2];
    const char* cA = (const char*)g.A + (size_t)cur.pm * tstep; const char* cB = (const char*)g.Bt + (size_t)cur.pn * tstep;
    S.a_ready(cur);
    if constexpr (SP2) {
        PG8_STAGE(PG8_SB(0, 0), cB, voffB); PG8_STAGE(PG8_SB(0, 1), cB + hstep, voffB); PG8_STAGE(PG8_SA(0, 0), cA, voffA); PG8_STAGE(PG8_SA(0, 1), cA + hstep, voffA);
        if (wr == 1) PG8_BAR;
        PG8_WAIT_V(2); PG8_BAR;
        PG8_STAGE(PG8_SB(1, 0), cB + kstep, voffB); PG8_STAGE(PG8_SA(1, 0), cA + kstep, voffA); PG8_STAGE(PG8_SB(1, 1), cB + hstep + kstep, voffB);
        PG8_WAIT_V(6); PG8_BAR;
    } else {
        PG8_STAGE(PG8_SB(0, 0), cB, voffB); PG8_STAGE(PG8_SA(0, 0), cA, voffA); PG8_STAGE(PG8_SB(0, 1), cB + hstep, voffB); PG8_STAGE(PG8_SA(0, 1), cA + hstep, voffA);
        if (wr == 1) PG8_BAR;
        PG8_WAIT_V(4); PG8_BAR;
        PG8_STAGE(PG8_SB(1, 0), cB + kstep, voffB); PG8_STAGE(PG8_SA(1, 0), cA + kstep, voffA); PG8_STAGE(PG8_SB(1, 1), cB + hstep + kstep, voffB);
        PG8_WAIT_V(6); PG8_BAR;
    }
    for (;;) {
        const bool has_next = S.next(ui + 1, nxt);
        const char* nA = has_next ? (const char*)g.A + (size_t)nxt.pm * tstep : cA; const char* nB = has_next ? (const char*)g.Bt + (size_t)nxt.pn * tstep : cB;
        for (int t = 0; t < nt; t += 2) {
            const bool last = (t == nt - 2);
            const char* a1 = cA + (size_t)(t + 1) * kstep;
            const char* a2 = last ? nA : cA + (size_t)(t + 2) * kstep; const char* b2 = last ? nB : cB + (size_t)(t + 2) * kstep;
            const char* a3 = a2 + kstep; const char* b3 = b2 + kstep;
            if (last && has_next) S.a_ready(nxt);
            if constexpr (SP2) {
            PG8_LDB(B0, 0, 0); PG8_LDB(B1, 0, 1); PG8_SCHED; PG8_LDA(At, 0, 0); PG8_STAGE(PG8_SA(1, 1), a1 + hstep, voffA);
            PG8_WAIT_V(8); PG8_WAIT_L(0); PG8_BAR; PG8_MMA(0, 0, At, B0); PG8_MMA(0, 1, At, B1); PG8_BAR; PG8_SCHED;
            PG8_LDA(At, 0, 1); PG8_STAGE(PG8_SB(0, 0), b2, voffB); PG8_STAGE(PG8_SB(0, 1), b2 + hstep, voffB); PG8_STAGE(PG8_SA(0, 0), a2, voffA);
            PG8_WAIT_V(8); PG8_WAIT_L(0); PG8_BAR; PG8_MMA(1, 0, At, B0); PG8_MMA(1, 1, At, B1); PG8_BAR; PG8_SCHED;
            PG8_LDB(B0, 1, 0); PG8_LDB(B1, 1, 1); PG8_SCHED; PG8_LDA(At, 1, 0); PG8_STAGE(PG8_SA(0, 1), a2 + hstep, voffA);
            PG8_WAIT_V(8); PG8_WAIT_L(0); PG8_BAR; PG8_MMA(0, 0, At, B0); PG8_MMA(0, 1, At, B1); PG8_BAR; PG8_SCHED;
            PG8_LDA(At, 1, 1); PG8_STAGE(PG8_SB(1, 0), b3, voffB); PG8_STAGE(PG8_SB(1, 1), b3 + hstep, voffB); PG8_STAGE(PG8_SA(1, 0), a3, voffA);
            PG8_WAIT_V(8); PG8_WAIT_L(0); PG8_BAR; PG8_MMA(1, 0, At, B0); PG8_MMA(1, 1, At, B1); PG8_BAR; PG8_SCHED;
            } else {
            PG8_LDB(B0, 0, 0); PG8_SCHED; PG8_LDA(At, 0, 0); PG8_STAGE(PG8_SA(1, 1), a1 + hstep, voffA);
            PG8_WAIT_L(8); PG8_BAR; PG8_WAIT_L(0); PG8_MMA(0, 0, At, B0); PG8_BAR; PG8_SCHED;
            PG8_LDB(B1, 0, 1); PG8_STAGE(PG8_SB(0, 0), b2, voffB);
            PG8_BAR; PG8_WAIT_L(0); PG8_MMA(0, 1, At, B1); PG8_BAR;
            PG8_LDA(At, 0, 1); PG8_STAGE(PG8_SA(0, 0), a2, voffA);
            PG8_BAR; PG8_WAIT_L(0); PG8_MMA(1, 0, At, B0); PG8_BAR; PG8_SCHED;
            PG8_STAGE(PG8_SB(0, 1), b2 + hstep, voffB);
            PG8_WAIT_V(6); PG8_BAR; PG8_MMA(1, 1, At, B1); PG8_BAR;
            PG8_LDB(B0, 1, 0); PG8_SCHED; PG8_LDA(At, 1, 0); PG8_STAGE(PG8_SA(0, 1), a2 + hstep, voffA);
            PG8_WAIT_L(8); PG8_BAR; PG8_WAIT_L(0); PG8_MMA(0, 0, At, B0); PG8_BAR; PG8_SCHED;
            PG8_LDB(B1, 1, 1); PG8_STAGE(PG8_SB(1, 0), b3, voffB);
            PG8_BAR; PG8_WAIT_L(0); PG8_MMA(0, 1, At, B1); PG8_BAR;
            PG8_LDA(At, 1, 1); PG8_STAGE(PG8_SA(1, 0), a3, voffA);
            PG8_BAR; PG8_WAIT_L(0); PG8_MMA(1, 0, At, B0); PG8_BAR; PG8_SCHED;
            PG8_STAGE(PG8_SB(1, 1), b3 + hstep, voffB);
            PG8_WAIT_V(6); PG8_BAR; PG8_MMA(1, 1, At, B1); PG8_BAR;
            }
        }
        if constexpr (ALIGN_EPI) { if (wr == 0) PG8_BAR; }
        if constexpr (!Epi::AFTER_DRAIN) { E(acc, cur, wr, wc, fr, fq); S.done(cur); }
        if (!has_next) break;
#pragma unroll
        for (int a = 0; a < 2; ++a)
#pragma unroll
            for (int b = 0; b < 2; ++b)
#pragma unroll
                for (int m = 0; m < 4; ++m)
#pragma unroll
                    for (int n = 0; n < 2; ++n) acc[a][b][m][n] = (f32x4){0.f, 0.f, 0.f, 0.f};
        cur = nxt; cA = nA; cB = nB; ++ui;
        if constexpr (ALIGN_EPI) { if (wr == 1) PG8_BAR; }
    }
    PG8_WAIT_V(0);
    if constexpr (!ALIGN_EPI) { if (wr == 0) PG8_BAR; }
    PG8_BAR;
    if constexpr (Epi::AFTER_DRAIN) { E.fused(acc, cur, wr, wc, fr, fq, lds, wid, lane); S.done(cur); }
#undef PG8_SA
#undef PG8_SB
#undef PG8_STAGE
#undef PG8_LDA
#undef PG8_LDB
#undef PG8_MMA
#undef PG8_WAIT_V
#undef PG8_WAIT_L
#undef PG8_BAR
#undef PG8_SCHED
}
}

#define DI __device__ __forceinline__
typedef unsigned short bf16_t;
typedef short bf16x8 __attribute__((ext_vector_type(8)));
typedef float f32x2 __attribute__((ext_vector_type(2)));
typedef float f32x4 __attribute__((ext_vector_type(4)));
typedef float f32x16 __attribute__((ext_vector_type(16)));
typedef unsigned u32x2 __attribute__((ext_vector_type(2)));
typedef unsigned u32x4 __attribute__((ext_vector_type(4)));
typedef __bf16 bf16x2_t __attribute__((ext_vector_type(2)));

constexpr int DM = 1024, NB = 8, SEQL = 4096, CTXL = 256;
constexpr int RC = NB * CTXL, RX = NB * SEQL, RT = RC + RX;
constexpr int INC = 3344, NIN = 3584, FH = 2816, NF1 = 5632;
constexpr float EPSV = 1e-6f;
constexpr int LDS_BYTES = 155648;

constexpr size_t WS_WIN = 0;
constexpr size_t WS_WO  = WS_WIN + (size_t)NIN * 1024 * 2;
constexpr size_t WS_WF1 = WS_WO + (size_t)1024 * 1024 * 2;
constexpr size_t WS_WF2 = WS_WF1 + (size_t)NF1 * 1024 * 2;
constexpr size_t WS_MOD = WS_WF2 + (size_t)1024 * FH * 2;
constexpr size_t WS_XC  = WS_MOD + (size_t)2 * 9 * 6144 * 4;
constexpr size_t WS_AB  = WS_XC + (size_t)RC * 1024 * 4;
constexpr size_t WS_PA  = WS_AB + (size_t)RT * 16 * 4;
constexpr size_t WS_PQ  = WS_PA + (size_t)RT * 768 * 2;
constexpr size_t WS_PZ  = WS_PQ + (size_t)RT * 1536 * 2;
constexpr size_t WS_G   = WS_PZ + (size_t)RT * 1024 * 2;
constexpr int    UNIT_BYTES = 116736;
constexpr int    NUNITS = 544 * 4;
constexpr size_t WS_BAR = WS_G + (size_t)NUNITS * UNIT_BYTES;
constexpr size_t WS_CTXB = WS_BAR + 16384;
constexpr size_t WS_END = WS_CTXB + (size_t)RC * 1024 * 2;
constexpr size_t WS_H    = WS_G;
constexpr size_t WS_YMIX = WS_G + (size_t)RT * 1024 * 2;
constexpr size_t WS_Y2   = WS_G + (size_t)RT * 1024 * 2;
constexpr size_t WS_YO   = WS_PA;
constexpr size_t WS_HID  = WS_PA;
constexpr size_t WS_OF   = WS_PQ;
constexpr size_t WS_OB   = WS_PQ + (size_t)RT * 512 * 2;
constexpr size_t WS_YAC  = WS_PQ + (size_t)RT * 1024 * 2;
static_assert(WS_Y2 + (size_t)RT * 1024 * 4 <= WS_END, "Y2 overlay");
static_assert(WS_HID + (size_t)RT * FH * 2 <= WS_G, "HID overlay");
constexpr int OFF_Q = 0, OFF_KT = 16384, OFF_D0 = 32768, DIR_BYTES = 40960, OFF_W = 0, OFF_QK = 16384, OFF_U = 24576, OFF_SC = 114688, SC_BYTES = 528;
constexpr int SCAN_BUF = 74752;

struct Params {
    const float *x, *c, *ctx, *c_ctx, *w_mod, *b_mod, *g_pre_mix, *g_post_mix, *g_pre_ffn, *g_post_ffn, *w_in, *conv_a, *conv_qkv, *a_log, *dt_bias,
                *g_onorm, *ln_c_g, *ln_c_b, *w_s, *b_s, *w_o, *w_ffn_in, *w_ffn_out;
    float* out; unsigned char* ws;
    int ph_lo, ph_hi;
};

DI unsigned pkbf(float lo, float hi) { f32x2 v = {lo, hi}; return __builtin_bit_cast(unsigned, __builtin_convertvector(v, bf16x2_t)); }
DI bf16_t bf1(float x) { return (bf16_t)(pkbf(x, 0.f) & 0xffffu); }
DI float bflo(unsigned w) { return __uint_as_float(w << 16); }
DI float bfhi(unsigned w) { return __uint_as_float(w & 0xffff0000u); }
DI float bf2f(bf16_t b) { return __uint_as_float(((unsigned)b) << 16); }
DI void unpack8(const u32x4 w, float* o) { o[0] = bflo(w.x); o[1] = bfhi(w.x); o[2] = bflo(w.y); o[3] = bfhi(w.y); o[4] = bflo(w.z); o[5] = bfhi(w.z); o[6] = bflo(w.w); o[7] = bfhi(w.w); }
DI u32x4 packw8(const float* v) { u32x4 w; w.x = pkbf(v[0], v[1]); w.y = pkbf(v[2], v[3]); w.z = pkbf(v[4], v[5]); w.w = pkbf(v[6], v[7]); return w; }
DI bf16x8 pack16s(const f32x16& x, const int s) {
    u32x4 w;
    if (s == 0) { w.x = pkbf(x[0], x[1]); w.y = pkbf(x[2], x[3]); w.z = pkbf(x[4], x[5]); w.w = pkbf(x[6], x[7]); }
    else        { w.x = pkbf(x[8], x[9]); w.y = pkbf(x[10], x[11]); w.z = pkbf(x[12], x[13]); w.w = pkbf(x[14], x[15]); }
    return __builtin_bit_cast(bf16x8, w);
}
#define MFMA32(a, b, c) __builtin_amdgcn_mfma_f32_32x32x16_bf16((a), (b), (c), 0, 0, 0)
DI int crow(int reg, int h) { return (reg & 3) + 8 * (reg >> 2) + 4 * h; }
DI float wave_sum(float v) {
#pragma unroll
    for (int o = 1; o < 64; o <<= 1) v += __shfl_xor(v, o);
    return v;
}
DI float siluf(float x) { return x / (1.f + expf(-x)); }
DI float sigmf(float x) { return 1.f / (1.f + expf(-x)); }
DI float geluf(float x) { return 0.5f * x * (1.f + erff(x * 0.70710678118654752f)); }
DI float fsilu(float x) { return x * __builtin_amdgcn_rcpf(1.f + __expf(-x)); }
DI float fgelu(float v) {
    const float av = fabsf(v), t = __builtin_amdgcn_rcpf(av * 0.2316418882f + 1.0f);
    float q = t * 0.5307027145f + (-0.7265760135f); q = q * t + 0.7107068705f; q = q * t + (-0.142248368f); q = q * t + 0.127414796f; q = q * t;
    const float e = __builtin_amdgcn_exp2f((v * v) * (-0.72134752044f));
    const float m = v * (q * e);
    return v < 0.f ? m : v - m;
}
DI float softplusf(float x) { return x > 20.f ? x : log1pf(expf(x)); }
#define LDS_WAIT() asm volatile("s_waitcnt lgkmcnt(0)" ::: "memory")
#define LBAR() asm volatile("s_waitcnt lgkmcnt(0)\n\ts_barrier" ::: "memory")

struct EpiBf16Out {
    static constexpr bool PERM = true, AFTER_DRAIN = false;
    bf16_t* out; int ldc;
    DI void operator()(const pg8::f32x4 (&acc)[2][2][4][2], const pg8::Unit& u, int wr, int wc, int fr, int fq) const {
        const int row0 = u.pm * 256 + wr * 64 + fr, col0 = u.pn * 256 + wc * 32 + 8 * fq;
#pragma unroll
        for (int ai = 0; ai < 2; ++ai)
#pragma unroll
            for (int m = 0; m < 4; ++m) { bf16_t* rp = out + (size_t)(row0 + ai * 128 + m * 16) * ldc + col0;
#pragma unroll
                for (int bj = 0; bj < 2; ++bj) { const pg8::f32x4 v0 = acc[ai][bj][m][0], v1 = acc[ai][bj][m][1];
                    u32x4 w; w.x = pkbf(v0[0], v0[1]); w.y = pkbf(v0[2], v0[3]); w.z = pkbf(v1[0], v1[1]); w.w = pkbf(v1[2], v1[3]);
                    *(u32x4*)(rp + bj * 128) = w; } }
    }
};
struct EpiInProj {
    static constexpr bool PERM = true, AFTER_DRAIN = false;
    bf16_t *PA, *PQ, *PZ; float* AB;
    DI void operator()(const pg8::f32x4 (&acc)[2][2][4][2], const pg8::Unit& u, int wr, int wc, int fr, int fq) const {
        const int row0 = u.pm * 256 + wr * 64 + fr;
        if (u.pn == 13) {
            if (wc == 0 && fq < 2) {
#pragma unroll
                for (int ai = 0; ai < 2; ++ai)
#pragma unroll
                    for (int m = 0; m < 4; ++m)
#pragma unroll
                        for (int n = 0; n < 2; ++n) *(pg8::f32x4*)(AB + (size_t)(row0 + ai * 128 + m * 16) * 16 + 8 * fq + 4 * n) = acc[ai][0][m][n];
            }
            return;
        }
        bf16_t* base; int ldc, coff;
        if (u.pn < 3) { base = PA; ldc = 768; coff = 256 * u.pn; }
        else if (u.pn < 9) { base = PQ; ldc = 1536; coff = 256 * (u.pn - 3); }
        else { base = PZ; ldc = 1024; coff = 256 * (u.pn - 9); }
        const int col0 = coff + wc * 32 + 8 * fq;
#pragma unroll
        for (int ai = 0; ai < 2; ++ai)
#pragma unroll
            for (int m = 0; m < 4; ++m) { bf16_t* rp = base + (size_t)(row0 + ai * 128 + m * 16) * ldc + col0;
#pragma unroll
                for (int bj = 0; bj < 2; ++bj) { const pg8::f32x4 v0 = acc[ai][bj][m][0], v1 = acc[ai][bj][m][1];
                    u32x4 w; w.x = pkbf(v0[0], v0[1]); w.y = pkbf(v0[2], v0[3]); w.z = pkbf(v1[0], v1[1]); w.w = pkbf(v1[2], v1[3]);
                    *(u32x4*)(rp + bj * 128) = w; } }
    }
};
struct EpiSwiglu {
    static constexpr bool PERM = true, AFTER_DRAIN = false;
    bf16_t* hid;
    DI void operator()(const pg8::f32x4 (&acc)[2][2][4][2], const pg8::Unit& u, int wr, int wc, int fr, int fq) const {
        const int row0 = u.pm * 256 + wr * 64 + fr, col0 = u.pn * 128 + wc * 32 + 8 * fq;
#pragma unroll
        for (int ai = 0; ai < 2; ++ai)
#pragma unroll
            for (int m = 0; m < 4; ++m) {
                float o[8];
#pragma unroll
                for (int n = 0; n < 2; ++n)
#pragma unroll
                    for (int j = 0; j < 4; ++j) { const float g = acc[ai][0][m][n][j], uu = acc[ai][1][m][n][j]; o[4 * n + j] = fsilu(g) * uu; }
                *(u32x4*)(hid + (size_t)(row0 + ai * 128 + m * 16) * FH + col0) = packw8(o);
            }
    }
};

DI void phase_mod(const Params& p, unsigned char* lds) {
    float* sc = (float*)lds;
    float* red = sc + 9 * 1024;
    float* MOD = (float*)(p.ws + WS_MOD);
    const int tid = opaque_tid();
    for (int it = opaque_bid(); it < 192; it += gridDim.x) {
        for (int i = tid; i < 9 * 1024; i += 512) { const int s = i >> 10, k = i & 1023; const float v = (s < 8) ? p.c[s * 1024 + k] : p.c_ctx[k]; sc[i] = siluf(v); }
        __syncthreads();
        const int l = it / 96, n0 = (it % 96) * 64, nn = tid & 63, kg = tid >> 6;
        const float* w = p.w_mod + ((size_t)l * 1024 + kg * 128) * 6144 + n0 + nn;
        float a[9];
#pragma unroll
        for (int s = 0; s < 9; ++s) a[s] = 0.f;
#pragma unroll 32
        for (int k = 0; k < 128; ++k) { const float wv = __builtin_nontemporal_load(w + (size_t)k * 6144);
#pragma unroll
            for (int s = 0; s < 9; ++s) a[s] += sc[s * 1024 + kg * 128 + k] * wv; }
#pragma unroll
        for (int s = 0; s < 9; ++s) red[(kg * 9 + s) * 64 + nn] = a[s];
        __syncthreads();
        for (int i = tid; i < 576; i += 512) { const int s = i >> 6, n2 = i & 63; float v = p.b_mod[l * 6144 + n0 + n2];
#pragma unroll
            for (int k2 = 0; k2 < 8; ++k2) v += red[(k2 * 9 + s) * 64 + n2];
            MOD[(size_t)(l * 9 + s) * 6144 + n0 + n2] = v; }
        __syncthreads();
    }
}
template <int MAP> DI int rowmap(int n) {
    if (MAP == 1) return n < 2304 ? n : (n < 2320 ? 3328 + (n - 2304) : n - 16);
    if (MAP == 2) { if (n < FH) return 256 * (n >> 7) + (n & 127); const int m = n - FH; return 256 * (m >> 7) + 128 + (m & 127); }
    return n;
}
template <int MAP> DI void tr_item(const float* W, int K, int N, bf16_t* WT, float* scr, int item, int lane) {
    const int nblk = (N + 31) / 32, kb = item / nblk, nb = item % nblk, k0 = 64 * kb, n0 = 32 * nb;
    const int nl = n0 + (lane & 31);
    float tv[32];
#pragma unroll
    for (int i = 0; i < 32; ++i) { const int kk = 2 * i + (lane >> 5); tv[i] = nl < N ? __builtin_nontemporal_load(W + (size_t)(k0 + kk) * N + nl) : 0.f; }
#pragma unroll
    for (int i = 0; i < 32; ++i) { const int kk = 2 * i + (lane >> 5); scr[kk * 33 + (lane & 31)] = tv[i]; }
    LDS_WAIT();
    const int c8 = lane & 7;
#pragma unroll
    for (int j = 0; j < 4; ++j) { const int n = (lane >> 3) + 8 * j; const float* s = scr + (8 * c8) * 33 + n;
        u32x4 o; o.x = pkbf(s[0], s[33]); o.y = pkbf(s[66], s[99]); o.z = pkbf(s[132], s[165]); o.w = pkbf(s[198], s[231]);
        if (n0 + n < N) *(u32x4*)(WT + (size_t)rowmap<MAP>(n0 + n) * K + k0 + 8 * c8) = o; }
    LDS_WAIT();
}
template <int PART> DI void phase_convert(const Params& p, int l, unsigned char* lds, int b0 = 0, int nb = 0) {
    const int tid = opaque_tid(), lane = tid & 63, wave = tid >> 6;
    float* scr = (float*)(lds + 65536) + wave * (64 * 33);
    bf16_t* WIN = (bf16_t*)(p.ws + WS_WIN); bf16_t* WO = (bf16_t*)(p.ws + WS_WO); bf16_t* WF1 = (bf16_t*)(p.ws + WS_WF1); bf16_t* WF2 = (bf16_t*)(p.ws + WS_WF2);
    constexpr int I_IN = 16 * 105, I_O = 16 * 32, I_F1 = 16 * 176, I_F2 = 44 * 32, NIT = I_IN + I_O + I_F1 + I_F2;
    const int gw = (PART == 0 ? opaque_bid() : opaque_bid() - b0) * 8 + wave, NGW = (PART == 0 ? (int)gridDim.x : nb) * 8;
    for (int it = (PART == 0 ? 0 : I_IN) + gw; it < (PART == 0 ? I_IN : NIT); it += NGW) {
        int r = it;
        if (r < I_IN) { tr_item<1>(p.w_in + (size_t)l * 1024 * INC, 1024, INC, WIN, scr, r, lane); continue; } r -= I_IN;
        if (r < I_O) { tr_item<0>(p.w_o + (size_t)l * 1024 * 1024, 1024, 1024, WO, scr, r, lane); continue; } r -= I_O;
        if (r < I_F1) { tr_item<2>(p.w_ffn_in + (size_t)l * 1024 * NF1, 1024, NF1, WF1, scr, r, lane); continue; } r -= I_F1;
        tr_item<0>(p.w_ffn_out + (size_t)l * FH * 1024, FH, 1024, WF2, scr, r, lane);
    }
    if (PART == 0) {
        u32x4* z = (u32x4*)(WIN + (size_t)INC * 1024);
        unsigned zz = 0u; asm volatile("" : "+v"(zz));
        const u32x4 zero = {zz, zz, zz, zz};
        for (int i = opaque_bid() * 512 + tid; i < (NIN - INC) * 1024 / 8; i += gridDim.x * 512) z[i] = zero;
    }
}

template <int MODE, bool WRITE_H> DI void rowpass(int row_lo, const float* xin_x, const float* xin_c, const bf16_t* Y, const bf16_t* Yb, const float* g_post, const float* mod_gate, int gate_idx,
                                    float* xout_x, float* xout_c, const float* g_pre, const float* mod_h, int shift_idx, bf16_t* H) {
    const int tid = opaque_tid(), lane = tid & 63, wave = tid >> 6;
    const int gw = opaque_bid() * 8 + wave, NGW = gridDim.x * 8;
    constexpr int NR = 4;
    for (int r0 = row_lo + gw * NR; r0 < RT; r0 += NGW * NR) {
        const int slot = r0 < RC ? 8 : ((r0 - RC) >> 12);
        const float* xr0 = r0 < RC ? xin_c + (size_t)r0 * 1024 : xin_x + (size_t)(r0 - RC) * 1024;
        f32x4 v[NR][4];
#pragma unroll
        for (int i = 0; i < NR; ++i)
#pragma unroll
            for (int j = 0; j < 4; ++j) v[i][j] = __builtin_nontemporal_load((const f32x4*)(xr0 + (size_t)i * 1024 + 4 * lane + 256 * j));
        u32x2 yw[NR][4]; f32x4 gp[4], gt[4], gpre[4], s1[4], s0[4];
        if (MODE == 1) {
            const float* gtp = mod_gate + (size_t)slot * 6144 + gate_idx * 1024;
#pragma unroll
            for (int i = 0; i < NR; ++i)
#pragma unroll
                for (int j = 0; j < 4; ++j) yw[i][j] = __builtin_nontemporal_load((const u32x2*)(Y + (size_t)(r0 + i) * 1024 + 4 * lane + 256 * j));
            if (Yb != nullptr && r0 < RC) {
                const bf16_t* Ybo = Yb; asm volatile("" : "+s"(Ybo));
#pragma unroll
                for (int i = 0; i < NR; ++i)
#pragma unroll
                    for (int j = 0; j < 4; ++j) { const u32x2 w2 = *(const u32x2*)(Ybo + (size_t)(r0 + i) * 1024 + 4 * lane + 256 * j);
                        yw[i][j].x = pkbf(bflo(yw[i][j].x) + bflo(w2.x), bfhi(yw[i][j].x) + bfhi(w2.x)); yw[i][j].y = pkbf(bflo(yw[i][j].y) + bflo(w2.y), bfhi(yw[i][j].y) + bfhi(w2.y)); }
            }
#pragma unroll
            for (int j = 0; j < 4; ++j) { gp[j] = *(const f32x4*)(g_post + 4 * lane + 256 * j); gt[j] = *(const f32x4*)(gtp + 4 * lane + 256 * j); }
        }
        if (WRITE_H) {
            const float* sh = mod_h + (size_t)slot * 6144 + shift_idx * 1024;
#pragma unroll
            for (int j = 0; j < 4; ++j) { gpre[j] = *(const f32x4*)(g_pre + 4 * lane + 256 * j); s0[j] = *(const f32x4*)(sh + 4 * lane + 256 * j); s1[j] = *(const f32x4*)(sh + 1024 + 4 * lane + 256 * j); }
        }
        if (MODE == 1) {
            float ss[NR];
#pragma unroll
            for (int i = 0; i < NR; ++i) { ss[i] = 0.f;
#pragma unroll
                for (int j = 0; j < 4; ++j) { const float a = bflo(yw[i][j].x), b2 = bfhi(yw[i][j].x), c2 = bflo(yw[i][j].y), d2 = bfhi(yw[i][j].y); ss[i] += (a * a + b2 * b2) + (c2 * c2 + d2 * d2); } }
#pragma unroll
            for (int o = 1; o < 64; o <<= 1) {
#pragma unroll
                for (int i = 0; i < NR; ++i) ss[i] += __shfl_xor(ss[i], o); }
            float* xo0 = r0 < RC ? xout_c + (size_t)r0 * 1024 : xout_x + (size_t)(r0 - RC) * 1024;
#pragma unroll
            for (int i = 0; i < NR; ++i) { const float rstd = rsqrtf(ss[i] * (1.f / 1024.f) + EPSV);
#pragma unroll
                for (int j = 0; j < 4; ++j) { const f32x4 y = {bflo(yw[i][j].x), bfhi(yw[i][j].x), bflo(yw[i][j].y), bfhi(yw[i][j].y)};
                    v[i][j] = v[i][j] + gt[j] * (y * rstd * gp[j]); __builtin_nontemporal_store(v[i][j], (f32x4*)(xo0 + (size_t)i * 1024 + 4 * lane + 256 * j)); } }
        }
        if (WRITE_H) {
            float ss[NR];
#pragma unroll
            for (int i = 0; i < NR; ++i) { ss[i] = 0.f;
#pragma unroll
                for (int j = 0; j < 4; ++j) ss[i] += (v[i][j].x * v[i][j].x + v[i][j].y * v[i][j].y) + (v[i][j].z * v[i][j].z + v[i][j].w * v[i][j].w); }
#pragma unroll
            for (int o = 1; o < 64; o <<= 1) {
#pragma unroll
                for (int i = 0; i < NR; ++i) ss[i] += __shfl_xor(ss[i], o); }
#pragma unroll
            for (int i = 0; i < NR; ++i) { const float rstd = rsqrtf(ss[i] * (1.f / 1024.f) + EPSV);
#pragma unroll
                for (int j = 0; j < 4; ++j) { const f32x4 hv = v[i][j] * rstd * gpre[j] * (1.f + s1[j]) + s0[j];
                    u32x2 w; w.x = pkbf(hv.x, hv.y); w.y = pkbf(hv.z, hv.w);
                    *(u32x2*)(H + (size_t)(r0 + i) * 1024 + 4 * lane + 256 * j) = w; } }
        }
    }
}
#ifndef STEP_MASK
#define STEP_MASK 0xFF
#endif
#define STEPON(i) (((STEP_MASK) >> (i)) & 1)
DI void conv_silu16(const u32x4* raw, const float* cw, float* out) {
#pragma unroll
    for (int hb = 0; hb < 2; ++hb) {
        float xc[8], xp[8], xn[8]; unpack8(raw[2 + hb], xc); unpack8(raw[hb], xp); unpack8(raw[4 + hb], xn);
        const f32x4 w0a = *(const f32x4*)(cw + 8 * hb), w0b = *(const f32x4*)(cw + 8 * hb + 4);
        const f32x4 w1a = *(const f32x4*)(cw + 1536 + 8 * hb), w1b = *(const f32x4*)(cw + 1536 + 8 * hb + 4);
        const f32x4 w2a = *(const f32x4*)(cw + 3072 + 8 * hb), w2b = *(const f32x4*)(cw + 3072 + 8 * hb + 4);
#pragma unroll
        for (int e = 0; e < 8; ++e) { const float w0 = e < 4 ? w0a[e & 3] : w0b[e & 3], w1 = e < 4 ? w1a[e & 3] : w1b[e & 3], w2 = e < 4 ? w2a[e & 3] : w2b[e & 3];
            out[8 * hb + e] = fsilu(w0 * xp[e] + w1 * xc[e] + w2 * xn[e]); }
    }
}
DI void load_rows16(const bf16_t* pp, bool hasp, bool hasn, u32x4* raw) {
    const u32x4 zero = {0u, 0u, 0u, 0u};
    raw[0] = hasp ? *(const u32x4*)(pp - 1536) : zero; raw[1] = hasp ? *(const u32x4*)(pp - 1536 + 8) : zero;
    raw[2] = *(const u32x4*)pp; raw[3] = *(const u32x4*)(pp + 8);
    raw[4] = hasn ? *(const u32x4*)(pp + 1536) : zero; raw[5] = hasn ? *(const u32x4*)(pp + 1536 + 8) : zero;
}

DI void phase_gdn_pre(const Params& p, int l, unsigned char* lds) {
    bf16_t* qL = (bf16_t*)lds;
    bf16_t* kL = qL + 64 * 136;
    bf16_t* kT = kL + 64 * 136;
    bf16_t* vT = kT + 128 * 72;
    float*  LF = (float*)(vT + 128 * 72);
    float*  LB = LF + 4096;
    bf16_t* TU = (bf16_t*)(LB + 4096);
    bf16_t* TW = TU + 2 * 64 * 72;
    float*  gv = (float*)(TW + 2 * 64 * 72);
    const bf16_t* PQ = (const bf16_t*)(p.ws + WS_PQ);
    const float* AB = (const float*)(p.ws + WS_AB);
    const float* cwq = p.conv_qkv + (size_t)l * 3 * 1536;
#define GDN_LOAD_UNIT(unx, tidx) do { const int cid_ = (unx) >> 2, h_ = (unx) & 3, c_ = (tidx) >> 3, cgp_ = (tidx) & 7, row_ = cid_ * 64 + c_; \
        const int pos_ = (cid_ < 32) ? ((cid_ & 3) * 64 + c_) : (((cid_ - 32) & 63) * 64 + c_); const int slen_ = (cid_ < 32) ? CTXL : SEQL; \
        const bool hasp_ = pos_ > 0, hasn_ = pos_ < slen_ - 1; const bf16_t* prow_ = PQ + (size_t)row_ * 1536 + h_ * 128 + cgp_ * 16; \
        load_rows16(prow_, hasp_, hasn_, rawq); load_rows16(prow_ + 512, hasp_, hasn_, rawk); load_rows16(prow_ + 1024, hasp_, hasn_, rawv); } while (0)
    for (int uo = opaque_bid(); uo < NUNITS; uo += gridDim.x) {
        int un;
        if (uo < 2048) { const int t = 31 - (uo >> 6), w = uo & 63, n = (w >> 5) ? 63 - t : t; un = (32 + ((w >> 2) & 7) * 64 + n) * 4 + (w & 3); }
        else un = uo - 2048;
        const int tid = opaque_tid();
        const int lane = tid & 63, wave = __builtin_amdgcn_readfirstlane(tid >> 6), r = lane & 31, hh = lane >> 5;
        const int cid = un >> 2, h = un & 3;
        unsigned char* GU = p.ws + WS_G + (size_t)un * UNIT_BYTES;
        u32x4 rawq[6], rawk[6], rawv[6];
        GDN_LOAD_UNIT(un, tid);
        float ab0 = 0.f, ab1 = 0.f, ab2 = 0.f, ab3 = 0.f;
        if (wave == 0) { const float* ab = AB + (size_t)(cid * 64 + lane) * 16; ab0 = ab[h]; ab1 = ab[4 + h]; ab2 = ab[8 + h]; ab3 = ab[12 + h]; }
        if (STEPON(0)) {
            const int c = tid >> 3, cgp = tid & 7;
            const float* cw = cwq + h * 128 + cgp * 16;
            float t[16];
            conv_silu16(rawq, cw, t);
            { float ss = 0.f;
#pragma unroll
              for (int e = 0; e < 16; ++e) ss += t[e] * t[e];
              ss += __shfl_xor(ss, 1); ss += __shfl_xor(ss, 2); ss += __shfl_xor(ss, 4);
              const float sc = rsqrtf(ss + EPSV) * 0.08838834764831845f;
#pragma unroll
              for (int e = 0; e < 16; ++e) t[e] *= sc; }
            { const u32x4 w0 = packw8(t), w1 = packw8(t + 8);
              *(u32x4*)(qL + c * 136 + cgp * 16) = w0; *(u32x4*)(qL + c * 136 + cgp * 16 + 8) = w1;
              const int frag = ((c >> 5) * 4 + (cgp >> 1)) * 2 + (cgp & 1);
              u32x4 f0, f1; f0.x = w0.x; f0.y = w0.y; f0.z = w1.x; f0.w = w1.y; f1.x = w0.z; f1.y = w0.w; f1.z = w1.z; f1.w = w1.w;
              u32x4* gq = (u32x4*)(GU + OFF_Q + frag * 1024);
              gq[c & 31] = f0; gq[32 + (c & 31)] = f1; }
            conv_silu16(rawk, cw + 512, t);
            { float ss = 0.f;
#pragma unroll
              for (int e = 0; e < 16; ++e) ss += t[e] * t[e];
              ss += __shfl_xor(ss, 1); ss += __shfl_xor(ss, 2); ss += __shfl_xor(ss, 4);
              const float sc = rsqrtf(ss + EPSV);
#pragma unroll
              for (int e = 0; e < 16; ++e) t[e] *= sc; }
            { *(u32x4*)(kL + c * 136 + cgp * 16) = packw8(t); *(u32x4*)(kL + c * 136 + cgp * 16 + 8) = packw8(t + 8);
#pragma unroll
              for (int e = 0; e < 16; ++e) kT[(cgp * 16 + e) * 72 + (c ^ (8 * cgp))] = bf1(t[e]); }
            conv_silu16(rawv, cw + 1024, t);
#pragma unroll
            for (int e = 0; e < 16; ++e) vT[(cgp * 16 + e) * 72 + (c ^ (8 * cgp))] = bf1(t[e]);
        }
        if (STEPON(1) && wave == 0) {
            const float bf_ = sigmf(ab0), bb_ = sigmf(ab1);
            float gf_ = -expf(p.a_log[l * 8 + h]) * softplusf(ab2 + p.dt_bias[l * 8 + h]);
            float gb_ = -expf(p.a_log[l * 8 + 4 + h]) * softplusf(ab3 + p.dt_bias[l * 8 + 4 + h]);
#pragma unroll
            for (int o = 1; o < 64; o <<= 1) { const float t1 = __shfl_up(gf_, o); if (lane >= o) gf_ += t1; const float t2 = __shfl_down(gb_, o); if (lane + o < 64) gb_ += t2; }
            gv[lane] = gf_; gv[64 + lane] = gb_; gv[128 + lane] = bf_; gv[192 + lane] = bb_;
            const float gfl = __shfl(gf_, 63), gbl = __shfl(gb_, 0);
            float* sc = (float*)(GU + OFF_SC);
            sc[lane] = expf(gf_); sc[64 + lane] = expf(gfl - gf_); if (lane < 4) sc[128 + lane] = expf(gfl);
            sc[132 + lane] = expf(gb_); sc[196 + lane] = expf(gbl - gb_); if (lane < 4) sc[260 + lane] = expf(gbl);
        }
        LBAR();
        if (STEPON(2)) {
            const int kind = wave >> 2, ti = (wave >> 1) & 1, tj = wave & 1;
            const bf16_t* Ab = kL + (32 * ti + r) * 136 + 8 * hh;
            const bf16_t* Bb = (kind ? qL : kL) + (32 * tj + r) * 136 + 8 * hh;
            f32x16 z;
#pragma unroll
            for (int i = 0; i < 16; ++i) z[i] = 0.f;
#pragma unroll
            for (int ks = 0; ks < 8; ++ks) z = MFMA32(*(const bf16x8*)(Ab + 16 * ks), *(const bf16x8*)(Bb + 16 * ks), z);
            const int cj = 32 * tj + r;
            const float gFj = gv[cj], gBj = gv[64 + cj];
            if (kind == 0) {
#pragma unroll
                for (int i = 0; i < 16; ++i) { const int ci = 32 * ti + crow(i, hh);
                    const float gFi = gv[ci], gBi = gv[64 + ci];
                    LF[ci * 64 + cj] = ci > cj ? z[i] * __expf(fminf(gFi - gFj, 0.f)) * gv[128 + ci] : 0.f;
                    LB[(63 - ci) * 64 + (63 - cj)] = ci < cj ? z[i] * __expf(fminf(gBi - gBj, 0.f)) * gv[192 + ci] : 0.f; }
            } else {
                f32x16 vf, vb;
#pragma unroll
                for (int i = 0; i < 16; ++i) { const int cp = 32 * ti + crow(i, hh);
                    vf[i] = cj >= cp ? z[i] * __expf(fminf(gFj - gv[cp], 0.f)) : 0.f;
                    vb[i] = cj <= cp ? z[i] * __expf(fminf(gBj - gv[64 + cp], 0.f)) : 0.f; }
#pragma unroll
                for (int s = 0; s < 2; ++s) {
                    *(bf16x8*)(GU + OFF_D0 + OFF_QK + ((tj * 2 + ti) * 2 + s) * 1024 + lane * 16) = pack16s(vf, s);
                    *(bf16x8*)(GU + OFF_D0 + DIR_BYTES + OFF_QK + ((tj * 2 + ti) * 2 + s) * 1024 + lane * 16) = pack16s(vb, s); }
            }
        }
        LBAR();
        if (STEPON(3) && wave < 2) {
            unsigned la = (unsigned)(size_t)(PG8_LAS float*)LF + (wave ? 16384u : 0u); asm volatile("" : "+v"(la));
            const PG8_LAS float* L = (const PG8_LAS float*)la;
            f32x2 T2[32];
#define TT(m) (T2[(m) >> 1][(m) & 1])
            f32x4 lcur[16], lnxt[16];
#pragma unroll
            for (int m4 = 0; m4 < 16; ++m4) { lcur[m4] = (f32x4){0.f, 0.f, 0.f, 0.f}; lnxt[m4] = lcur[m4]; }
#pragma unroll
            for (int k = 0; k < 32; ++k) T2[k] = (f32x2){0.f, 0.f};
            lcur[0] = *(const PG8_LAS f32x4*)(L + 64);
            T2[0][0] = (lane == 0) ? 1.f : 0.f;
#pragma unroll
            for (int i = 1; i < 64; ++i) {
                if (i + 1 < 64) {
#pragma unroll
                    for (int m4 = 0; m4 < (i + 4) / 4; ++m4) lnxt[m4] = *(const PG8_LAS f32x4*)(L + (i + 1) * 64 + 4 * m4);
                }
                __builtin_amdgcn_sched_barrier(0);
                f32x2 a0 = {(lane == i) ? 1.f : 0.f, 0.f}, a1 = {0.f, 0.f};
#pragma unroll
                for (int k = 0; k < i / 2; ++k) {
                    const f32x2 l2 = (k & 1) ? (f32x2){lcur[k >> 1][2], lcur[k >> 1][3]} : (f32x2){lcur[k >> 1][0], lcur[k >> 1][1]};
                    if (k & 1) a1 -= l2 * T2[k]; else a0 -= l2 * T2[k]; }
                float rsum = (a0[0] + a0[1]) + (a1[0] + a1[1]);
                if (i & 1) rsum -= lcur[(i - 1) >> 2][(i - 1) & 3] * TT(i - 1);
                TT(i) = rsum;
                __builtin_amdgcn_sched_barrier(0);
#pragma unroll
                for (int m4 = 0; m4 < (i + 4) / 4; ++m4) lcur[m4] = lnxt[m4];
            }
            const int cj = wave ? 63 - lane : lane;
            const float bj = gv[(wave ? 192 : 128) + cj], ej = expf(gv[(wave ? 64 : 0) + cj]);
            unsigned tu = (unsigned)(size_t)(PG8_LAS bf16_t*)TU + (wave ? (4608u + (unsigned)cj) * 2u : (unsigned)cj * 2u); asm volatile("" : "+v"(tu));
            PG8_LAS bf16_t* TUp = (PG8_LAS bf16_t*)tu; PG8_LAS bf16_t* TWp = TUp + 2 * 64 * 72;
            if (wave == 0) {
#pragma unroll
                for (int i = 0; i < 64; ++i) { TUp[i * 72] = bf1(TT(i) * bj); TWp[i * 72] = bf1(TT(i) * bj * ej); }
            } else {
#pragma unroll
                for (int i = 0; i < 64; ++i) { TUp[(63 - i) * 72] = bf1(TT(i) * bj); TWp[(63 - i) * 72] = bf1(TT(i) * bj * ej); }
            }
        }
        LBAR();
#pragma unroll
        for (int q4 = 0; q4 < (STEPON(4) ? 4 : 0); ++q4) {
            const int d = q4 >> 1, kind = q4 & 1;
            f32x16 z;
#pragma unroll
            for (int i = 0; i < 16; ++i) z[i] = 0.f;
            if (kind == 0) {
                const int tM = wave >> 1, tN = wave & 1;
                const int swz = 8 * (((32 * tM + r) >> 4) & 7);
                const bf16_t* Ab = kT + (32 * tM + r) * 72;
                const bf16_t* Bb = TW + d * 4608 + (32 * tN + r) * 72 + 8 * hh;
#pragma unroll
                for (int ks = 0; ks < 4; ++ks) z = MFMA32(*(const bf16x8*)(Ab + ((8 * hh + 16 * ks) ^ swz)), *(const bf16x8*)(Bb + 16 * ks), z);
#pragma unroll
                for (int s = 0; s < 2; ++s) *(bf16x8*)(GU + OFF_D0 + d * DIR_BYTES + OFF_W + ((tN * 4 + tM) * 2 + s) * 1024 + lane * 16) = pack16s(z, s);
            } else {
                const int tM = wave >> 2, tN = wave & 3;
                const bf16_t* Ab = TU + d * 4608 + (32 * tM + r) * 72 + 8 * hh;
                const int swz = 8 * (((32 * tN + r) >> 4) & 7);
                const bf16_t* Bb = vT + (32 * tN + r) * 72;
#pragma unroll
                for (int ks = 0; ks < 4; ++ks) z = MFMA32(*(const bf16x8*)(Ab + 16 * ks), *(const bf16x8*)(Bb + ((8 * hh + 16 * ks) ^ swz)), z);
                bf16x8* gu = (bf16x8*)(GU + OFF_D0 + d * DIR_BYTES + OFF_U + ((tN * 2 + tM) * 64 + lane) * 32);
                gu[0] = pack16s(z, 0); gu[1] = pack16s(z, 1);
            }
        }
#pragma unroll
        for (int f2 = 0; f2 < 2; ++f2) { const int fl = tid + 512 * f2, f = fl >> 6, ln = fl & 63, r2 = ln & 31, h2 = ln >> 5, mt = f >> 2, kt = (f >> 1) & 1, s = f & 1;
            const int swz = 8 * (((32 * mt + r2) >> 4) & 7), c0 = 32 * kt + 16 * s + 4 * h2;
            const bf16_t* src = kT + (32 * mt + r2) * 72;
            const u32x2 lo = *(const u32x2*)(src + (c0 ^ swz)), hi = *(const u32x2*)(src + ((c0 + 8) ^ swz));
            u32x4 o; o.x = lo.x; o.y = lo.y; o.z = hi.x; o.w = hi.y;
            *(u32x4*)(GU + OFF_KT + f * 1024 + ln * 16) = o; }
        LBAR();
    }
}

DI int scan_cid(int b, int d, int st) { return st < 4 ? (b * 4 + (d ? 3 - st : st)) : (32 + b * 64 + (d ? 67 - st : st - 4)); }
DI void phase_scan(const Params& p, int l, unsigned char* lds) {
    const int bid = opaque_bid();
    if (bid >= 64) return;
    const int b = bid >> 3, h = (bid >> 1) & 3, d = bid & 1;
    const unsigned char* G = p.ws + WS_G;
    bf16_t* OD = (bf16_t*)(p.ws + (d ? WS_OB : WS_OF));
    const int tid0 = opaque_tid();
    if (__builtin_amdgcn_readfirstlane(tid0 >> 6) >= 4) {
        const int lt = tid0 - 256;
#define SCAN_SRC(U, o) ((o) < 32768 ? (U) + (o) : (U) + OFF_D0 + d * DIR_BYTES + ((o) - 32768))
#define SCAN_LD(set, sets, step) do { const unsigned char* U_ = G + (size_t)(scan_cid(b, d, (step)) * 4 + h) * UNIT_BYTES; \
        _Pragma("unroll") for (int i_ = 0; i_ < 18; ++i_) { const int o_ = (lt + 256 * i_) * 16; set[i_] = *(const u32x4*)SCAN_SRC(U_, o_); } \
        if (lt < 33) sets = *(const u32x4*)(U_ + OFF_SC + d * SC_BYTES + lt * 16); } while (0)
#define SCAN_ST(set, sets, step) do { unsigned char* dst_ = lds + ((step) & 1) * SCAN_BUF; \
        _Pragma("unroll") for (int i_ = 0; i_ < 18; ++i_) *(u32x4*)(dst_ + (lt + 256 * i_) * 16) = set[i_]; \
        if (lt < 33) *(u32x4*)(dst_ + 73728 + lt * 16) = sets; } while (0)
        u32x4 sA[18], sB[18]; u32x4 sAs = {0u, 0u, 0u, 0u}, sBs = sAs;
        SCAN_LD(sA, sAs, 0); SCAN_ST(sA, sAs, 0);
        SCAN_LD(sA, sAs, 1); SCAN_LD(sB, sBs, 2);
        LBAR();
        unsigned* prog = (unsigned*)(p.ws + WS_BAR + 14336) + bid * 8;
        for (int st = 0; st < 68; st += 2) {
            SCAN_ST(sA, sAs, st + 1);
            if (st + 3 < 68) SCAN_LD(sA, sAs, st + 3);
            LBAR();
            if (lt == 0) __hip_atomic_store(prog, (unsigned)(l * 1000 + st + 1), __ATOMIC_RELAXED, __HIP_MEMORY_SCOPE_AGENT);
            if (st + 2 < 68) SCAN_ST(sB, sBs, st + 2);
            if (st + 4 < 68) SCAN_LD(sB, sBs, st + 4);
            LBAR();
            if (lt == 0) __hip_atomic_store(prog, (unsigned)(l * 1000 + st + 2), __ATOMIC_RELAXED, __HIP_MEMORY_SCOPE_AGENT);
        }
        return;
    }
    LBAR();
    f32x16 S[4];
#pragma unroll
    for (int k = 0; k < 4; ++k)
#pragma unroll
        for (int i = 0; i < 16; ++i) S[k][i] = 0.f;
    for (int st = 0; st < 68; ++st) {
        const int cur = st & 1;
        const int cid = scan_cid(b, d, st);
        int tidv = threadIdx.x; asm volatile("" : "+v"(tidv));
        const int lane = tidv & 63, wave = __builtin_amdgcn_readfirstlane(tidv >> 6), r = lane & 31, hh = lane >> 5;
        {
            const unsigned char* B0 = lds + cur * SCAN_BUF;
            const bf16x8* Aq = (const bf16x8*)(B0) + lane;
            const bf16x8* AkT = (const bf16x8*)(B0 + 16384) + lane;
            const bf16x8* Aw = (const bf16x8*)(B0 + 32768) + lane;
            const bf16x8* Aqk = (const bf16x8*)(B0 + 49152) + lane;
            const float* scl = (const float*)(B0 + 73728);
            const unsigned char* UU = B0 + 32768 + OFF_U;
            f32x16 ws[2], qs[2];
#pragma unroll
            for (int mt = 0; mt < 2; ++mt)
#pragma unroll
                for (int i = 0; i < 16; ++i) { ws[mt][i] = 0.f; qs[mt][i] = 0.f; }
#define SCAN_SB() __builtin_amdgcn_sched_barrier(0)
#define SCAN_LOADB(dst, kt) do { _Pragma("unroll") for (int s_ = 0; s_ < 2; ++s_) { const int f_ = (kt) * 2 + s_; dst[4 * s_ + 0] = Aw[f_ * 64]; dst[4 * s_ + 1] = Aw[(8 + f_) * 64]; dst[4 * s_ + 2] = Aq[f_ * 64]; dst[4 * s_ + 3] = Aq[(8 + f_) * 64]; } } while (0)
#define SCAN_MMAB(src, kt) do { _Pragma("unroll") for (int s_ = 0; s_ < 2; ++s_) { const bf16x8 sb_ = pack16s(S[kt], s_); ws[0] = MFMA32(src[4 * s_ + 0], sb_, ws[0]); ws[1] = MFMA32(src[4 * s_ + 1], sb_, ws[1]); qs[0] = MFMA32(src[4 * s_ + 2], sb_, qs[0]); qs[1] = MFMA32(src[4 * s_ + 3], sb_, qs[1]); } } while (0)
            bf16x8 fa[8], fb[8];
            SCAN_LOADB(fa, 0); SCAN_LOADB(fb, 1); SCAN_SB();
            SCAN_MMAB(fa, 0); SCAN_SB(); SCAN_LOADB(fa, 2); SCAN_SB();
            SCAN_MMAB(fb, 1); SCAN_SB(); SCAN_LOADB(fb, 3); SCAN_SB();
            SCAN_MMAB(fa, 2); SCAN_SB();
#pragma unroll
            for (int i = 0; i < 8; ++i) fa[i] = Aqk[i * 64];
            SCAN_SB();
            SCAN_MMAB(fb, 3); SCAN_SB();
            f32x16 vn[2];
#pragma unroll
            for (int mt = 0; mt < 2; ++mt) {
                const u32x4* up = (const u32x4*)(UU + ((wave * 2 + mt) * 64 + lane) * 32);
                const u32x4 u0 = up[0], u1 = up[1];
                f32x4 es[4];
#pragma unroll
                for (int g = 0; g < 4; ++g) es[g] = *(const f32x4*)(scl + 32 * mt + 8 * g + 4 * hh);
                float uf[16]; unpack8(u0, uf); unpack8(u1, uf + 8);
#pragma unroll
                for (int i = 0; i < 16; ++i) vn[mt][i] = uf[i] - ws[mt][i];
#pragma unroll
                for (int g = 0; g < 4; ++g)
#pragma unroll
                    for (int j = 0; j < 4; ++j) qs[mt][4 * g + j] *= es[g][j];
            }
            SCAN_SB();
#pragma unroll
            for (int i = 0; i < 8; ++i) fb[i] = AkT[i * 64];
            SCAN_SB();
            {
                bf16x8 vb[2][2];
#pragma unroll
                for (int kt = 0; kt < 2; ++kt)
#pragma unroll
                    for (int s = 0; s < 2; ++s) vb[kt][s] = pack16s(vn[kt], s);
#pragma unroll
                for (int kt = 0; kt < 2; ++kt)
#pragma unroll
                    for (int s = 0; s < 2; ++s) { qs[0] = MFMA32(fa[(0 * 2 + kt) * 2 + s], vb[kt][s], qs[0]); qs[1] = MFMA32(fa[(1 * 2 + kt) * 2 + s], vb[kt][s], qs[1]); }
            }
            SCAN_SB();
#pragma unroll
            for (int i = 0; i < 8; ++i) fa[i] = AkT[(8 + i) * 64];
            f32x4 et[2][4];
#pragma unroll
            for (int mt = 0; mt < 2; ++mt)
#pragma unroll
                for (int g = 0; g < 4; ++g) et[mt][g] = *(const f32x4*)(scl + 64 + 32 * mt + 8 * g + 4 * hh);
            const float decay = scl[128];
            SCAN_SB();
            {
                bf16x8 vt[2][2];
#pragma unroll
                for (int mt = 0; mt < 2; ++mt) {
#pragma unroll
                    for (int g = 0; g < 4; ++g)
#pragma unroll
                        for (int j = 0; j < 4; ++j) vn[mt][4 * g + j] *= et[mt][g][j];
                    vt[mt][0] = pack16s(vn[mt], 0); vt[mt][1] = pack16s(vn[mt], 1);
                }
#pragma unroll
                for (int mt = 0; mt < 4; ++mt) {
#pragma unroll
                    for (int i = 0; i < 16; ++i) S[mt][i] *= decay;
#pragma unroll
                    for (int kt = 0; kt < 2; ++kt)
#pragma unroll
                        for (int s = 0; s < 2; ++s) S[mt] = MFMA32((mt < 2 ? fb : fa)[((mt & 1) * 2 + kt) * 2 + s], vt[kt][s], S[mt]);
                }
            }
            if (l == 0 || cid >= 32) {
#pragma unroll
                for (int mt = 0; mt < 2; ++mt)
#pragma unroll
                    for (int i = 0; i < 16; ++i) OD[(size_t)(cid * 64 + 32 * mt + crow(i, hh)) * 512 + h * 128 + 32 * wave + r] = bf1(qs[mt][i]);
            }
        }
        LBAR();
    }
}

DI void scan_helper(const Params& p, int l, int s) {
    const int b = s >> 3, h = (s >> 1) & 3, d = s & 1;
    const unsigned char* G = p.ws + WS_G;
    unsigned* prog = (unsigned*)(p.ws + WS_BAR + 14336) + s * 8;
    constexpr int LEAD = 5;
    unsigned acc = 0u;
    for (int st = 4; st < 68; ++st) {
        const int tid = opaque_tid();
        if (tid == 0) { const int want = l * 1000 + st - LEAD; while ((int)__hip_atomic_load(prog, __ATOMIC_RELAXED, __HIP_MEMORY_SCOPE_AGENT) < want) __builtin_amdgcn_s_sleep(8); }
        LBAR();
        const unsigned char* U = G + (size_t)(scan_cid(b, d, st) * 4 + h) * UNIT_BYTES;
        for (int ln = tid; ln < 581; ln += 512) {
            const int off = ln < 256 ? ln * 128 : (ln < 576 ? OFF_D0 + d * DIR_BYTES + (ln - 256) * 128 : OFF_SC + d * SC_BYTES + (ln - 576) * 128);
            acc += *(const unsigned*)(U + off);
        }
    }
    if (acc == 0x9e3779b9u) prog[1] = acc;
}

template <int MODE> DI void phase_mix(const Params& p, int l, unsigned char* lds, int b0, int nb) {
    const bf16_t* PA = (const bf16_t*)(p.ws + WS_PA);
    const bf16_t* PZ = (const bf16_t*)(p.ws + WS_PZ);
    const bf16_t* OF = (const bf16_t*)(p.ws + WS_OF);
    const bf16_t* OB = (const bf16_t*)(p.ws + WS_OB);
    bf16_t* YM = (bf16_t*)(p.ws + WS_YMIX);
    bf16_t* YAC = (bf16_t*)(p.ws + WS_YAC);
    const int cu_lo = l ? 16 : 0, cid_lo = l ? 32 : 0;
    const int nC = MODE == 0 ? 272 - cu_lo : 0, nAB = 544 - cid_lo;
    for (int un = opaque_bid() - b0; un < nC + nAB; un += nb) {
        const int tid = opaque_tid(), lane = tid & 63, wave = __builtin_amdgcn_readfirstlane(tid >> 6), r = lane & 31, hh = lane >> 5;
        if (un < nC) {
            const int R0 = (cu_lo + un) * 128;
            bf16_t* vT = (bf16_t*)lds;
            {
                const int rr = tid >> 2, g = tid & 3, row = R0 + rr;
                const bf16_t* src = PZ + (size_t)row * 1024 + 768 + g * 64;
                float v[64];
#pragma unroll
                for (int i = 0; i < 8; ++i) unpack8(*(const u32x4*)(src + 8 * i), v + 8 * i);
                float sum = 0.f;
#pragma unroll
                for (int e = 0; e < 64; ++e) { v[e] = fgelu(v[e]); sum += v[e]; }
                sum += __shfl_xor(sum, 1); sum += __shfl_xor(sum, 2);
                const float mu = sum * (1.f / 256.f);
                float var = 0.f;
#pragma unroll
                for (int e = 0; e < 64; ++e) { const float dlt = v[e] - mu; var += dlt * dlt; }
                var += __shfl_xor(var, 1); var += __shfl_xor(var, 2);
                const float rstd = rsqrtf(var * (1.f / 256.f) + EPSV);
                const float* lg = p.ln_c_g + l * 256 + g * 64; const float* lb = p.ln_c_b + l * 256 + g * 64;
#pragma unroll
                for (int e = 0; e < 64; ++e) vT[(g * 64 + e) * 136 + rr] = bf1((v[e] - mu) * rstd * lg[e] + lb[e]);
            }
            LBAR();
            {
                const int g2 = wave >> 1, ph = wave & 1;
                f32x16 acc[2][2];
#pragma unroll
                for (int a = 0; a < 2; ++a)
#pragma unroll
                    for (int bq = 0; bq < 2; ++bq)
#pragma unroll
                        for (int i = 0; i < 16; ++i) acc[a][bq][i] = 0.f;
                const float* Wg = p.w_s + (size_t)(l * 4 + g2) * 128 * 128;
#pragma unroll 2
                for (int ks = 0; ks < 8; ++ks) {
                    bf16x8 a[2], bb[2];
#pragma unroll
                    for (int mt = 0; mt < 2; ++mt) { const float* wp = Wg + (size_t)(64 * ph + 32 * mt + r) * 128 + 16 * ks + 8 * hh;
                        const f32x4 w0 = *(const f32x4*)wp, w1 = *(const f32x4*)(wp + 4);
                        u32x4 w; w.x = pkbf(w0.x, w0.y); w.y = pkbf(w0.z, w0.w); w.z = pkbf(w1.x, w1.y); w.w = pkbf(w1.z, w1.w); a[mt] = __builtin_bit_cast(bf16x8, w); }
#pragma unroll
                    for (int nt = 0; nt < 2; ++nt) bb[nt] = *(const bf16x8*)(vT + (g2 * 64 + 32 * nt + r) * 136 + 16 * ks + 8 * hh);
#pragma unroll
                    for (int mt = 0; mt < 2; ++mt)
#pragma unroll
                        for (int nt = 0; nt < 2; ++nt) acc[mt][nt] = MFMA32(a[mt], bb[nt], acc[mt][nt]);
                }
                const float* bs = p.b_s + (size_t)(l * 4 + g2) * 128;
                bf16_t cuw[2][2][16];
#pragma unroll
                for (int mt = 0; mt < 2; ++mt)
#pragma unroll
                    for (int nt = 0; nt < 2; ++nt)
#pragma unroll
                        for (int i = 0; i < 16; ++i) { const int prow = 64 * ph + 32 * mt + crow(i, hh), row = R0 + prow, ch = g2 * 64 + 32 * nt + r;
                            cuw[mt][nt][i] = PZ[(size_t)row * 1024 + 512 + ch]; }
#pragma unroll
                for (int mt = 0; mt < 2; ++mt)
#pragma unroll
                    for (int nt = 0; nt < 2; ++nt)
#pragma unroll
                        for (int i = 0; i < 16; ++i) { const int prow = 64 * ph + 32 * mt + crow(i, hh), row = R0 + prow, ch = g2 * 64 + 32 * nt + r;
                            YAC[(size_t)row * 512 + 256 + ch] = bf1(fgelu(bf2f(cuw[mt][nt][i])) * (acc[mt][nt][i] + bs[prow])); }
            }
            LBAR();
        } else {
            const int cid = cid_lo + (un - nC);
            const int c = tid >> 3, sub = tid & 7, row = cid * 64 + c;
            const bool isctx = cid < 32;
            const int pos = isctx ? ((cid & 3) * 64 + c) : (((cid - 32) & 63) * 64 + c);
            {
                const bool vert = (!isctx) && (sub >= 4);
                const int dstep = vert ? 64 : 1;
                bool hasp, hasn;
                if (isctx) { hasp = pos > 0; hasn = pos < CTXL - 1; }
                else if (!vert) { const int col = pos & 63; hasp = col > 0; hasn = col < 63; }
                else { hasp = pos >= 64; hasn = pos < SEQL - 64; }
                const u32x4 zero = {0u, 0u, 0u, 0u};
                if (MODE == 0) {
                const bf16_t* pa = PA + (size_t)row * 768 + sub * 32;
#pragma unroll 1
                for (int hb2 = 0; hb2 < 4; hb2 += 2) {
                    u32x4 rab[2], rcc[2], rch[2], rpc[2], rph[2], rnc[2], rnh[2];
#pragma unroll
                    for (int q = 0; q < 2; ++q) { const int hb = hb2 + q;
                        rab[q] = *(const u32x4*)(pa + hb * 8); rcc[q] = *(const u32x4*)(pa + 256 + hb * 8); rch[q] = *(const u32x4*)(pa + 512 + hb * 8);
                        rpc[q] = hasp ? *(const u32x4*)(pa - (size_t)dstep * 768 + 256 + hb * 8) : zero; rph[q] = hasp ? *(const u32x4*)(pa - (size_t)dstep * 768 + 512 + hb * 8) : zero;
                        rnc[q] = hasn ? *(const u32x4*)(pa + (size_t)dstep * 768 + 256 + hb * 8) : zero; rnh[q] = hasn ? *(const u32x4*)(pa + (size_t)dstep * 768 + 512 + hb * 8) : zero; }
#pragma unroll
                    for (int q = 0; q < 2; ++q) { const int hb = hb2 + q;
                        const float* cw = p.conv_a + (size_t)l * 768 + sub * 32 + hb * 8;
                        float ab_[8], cc[8], ch_[8], pc[8], ph_[8], nc[8], nh[8];
                        unpack8(rab[q], ab_); unpack8(rcc[q], cc); unpack8(rch[q], ch_); unpack8(rpc[q], pc); unpack8(rph[q], ph_); unpack8(rnc[q], nc); unpack8(rnh[q], nh);
                        float o[8];
#pragma unroll
                        for (int e = 0; e < 8; ++e) o[e] = ab_[e] * (cw[e] * (pc[e] * ph_[e]) + cw[256 + e] * (cc[e] * ch_[e]) + cw[512 + e] * (nc[e] * nh[e]));
                        *(u32x4*)(YAC + (size_t)row * 512 + sub * 32 + hb * 8) = packw8(o); }
                }
                } else {
                const int head = sub >> 1, hf = sub & 1;
                const size_t ob = (size_t)row * 512 + head * 128 + hf * 64;
                const bf16_t* zp = PZ + (size_t)row * 1024 + head * 128 + hf * 64;
                u32x4 rof[8], rob[8], rz[8], rcp[8];
#pragma unroll
                for (int i = 0; i < 8; ++i) { rof[i] = *(const u32x4*)(OF + ob + 8 * i); rob[i] = *(const u32x4*)(OB + ob + 8 * i); rz[i] = *(const u32x4*)(zp + 8 * i);
                    rcp[i] = *(const u32x4*)(YAC + (size_t)row * 512 + sub * 64 + 8 * i); }
                { bf16_t* cd = YM + (size_t)row * 1024 + (sub < 4 ? sub * 64 : 768 + (sub - 4) * 64);
#pragma unroll
                  for (int i = 0; i < 8; ++i) *(u32x4*)(cd + 8 * i) = rcp[i]; }
                float ss = 0.f;
#pragma unroll
                for (int i = 0; i < 8; ++i) { float a[8], bq[8]; unpack8(rof[i], a); unpack8(rob[i], bq);
#pragma unroll
                    for (int e = 0; e < 8; ++e) { const float o = a[e] + bq[e]; ss += o * o; } }
                ss += __shfl_xor(ss, 1);
                const float rstd = rsqrtf(ss * (1.f / 128.f) + EPSV);
                const float* gw = p.g_onorm + l * 128 + hf * 64;
                bf16_t* yo = YM + (size_t)row * 1024 + 256 + head * 128 + hf * 64;
#pragma unroll
                for (int i = 0; i < 8; ++i) { float a[8], bq[8], zz[8], o[8]; unpack8(rof[i], a); unpack8(rob[i], bq); unpack8(rz[i], zz);
#pragma unroll
                    for (int e = 0; e < 8; ++e) o[e] = (a[e] + bq[e]) * rstd * gw[8 * i + e] * fsilu(zz[e]);
                    *(u32x4*)(yo + 8 * i) = packw8(o); }
                }
            }
        }
    }
}


#define LAS __attribute__((address_space(3)))
#define XB_TMO      128
#define XB_XCNT(j)  (256  + 64 * (j))
#define XB_XSUB(j)  (1280 + 64 * (j))
#define XB_XGEN(j)  (2304 + 64 * (j))
#define XB_TOP      3328
#define XB_TOPGEN   3392
#define XCD_BAR_WORDS 3456
#define XB_SPIN_CAP (1u << 18)

__device__ __forceinline__ unsigned xb_ld(unsigned* p)              { return __hip_atomic_load(p, __ATOMIC_RELAXED, __HIP_MEMORY_SCOPE_AGENT); }
__device__ __forceinline__ unsigned xb_add(unsigned* p, unsigned v) { return __hip_atomic_fetch_add(p, v, __ATOMIC_RELAXED, __HIP_MEMORY_SCOPE_AGENT); }
__device__ __forceinline__ unsigned xb_xcc_id() { return (unsigned)__builtin_amdgcn_s_getreg((3 << 11) | 20) & 0xFu; }
#define XB_SPIN(cond, bar) do { unsigned _sp = 0; while (cond) { __builtin_amdgcn_s_sleep(1); \
    if ((++_sp & 255u) == 0u) { if (xb_ld(&(bar)[XB_TMO])) break; if (_sp > XB_SPIN_CAP) { atomicAdd(&(bar)[XB_TMO], 1u); break; } } } } while (0)

struct XcdBarrier {
    unsigned* bar; unsigned x;
    volatile LAS unsigned* st;
};

__device__ __forceinline__ XcdBarrier xcd_barrier_post(unsigned* bar, volatile LAS unsigned* st) {
    XcdBarrier b; b.bar = bar; b.x = xb_xcc_id(); b.st = st;
    if (threadIdx.x == 0) (void)xb_add(&bar[XB_XCNT(b.x)], 1u);
    return b;
}
__device__ __forceinline__ void xcd_barrier_complete(unsigned* bar, unsigned x, unsigned& nloc, unsigned& nx) {
    const unsigned G = gridDim.x * gridDim.y * gridDim.z;
    unsigned sum, cnt, mine, sp = 0u;
    for (;;) {
        sum = 0u; cnt = 0u; mine = 0u;
#pragma unroll
        for (unsigned j = 0; j < 16; ++j) { const unsigned c = xb_ld(&bar[XB_XCNT(j)]); sum += c; cnt += (c > 0u) ? 1u : 0u; mine = (j == x) ? c : mine; }
        if (sum == G) break;
        __builtin_amdgcn_s_sleep(1);
        if ((++sp & 255u) == 0u) { if (xb_ld(&bar[XB_TMO])) break; if (sp > XB_SPIN_CAP) { atomicAdd(&bar[XB_TMO], 1u); break; } }
    }
    nloc = mine > 0u ? mine : 1u; nx = cnt > 0u ? cnt : 1u;
}

__device__ __forceinline__ void xcd_barrier(const XcdBarrier& b) {
    asm volatile("s_waitcnt vmcnt(0)" ::: "memory");
    __syncthreads();
    if (threadIdx.x == 0) {
        unsigned* bar = b.bar;
        __builtin_amdgcn_s_waitcnt(0);
        unsigned nloc = b.st[0], nx = b.st[1];
        if (nloc == 0u) { xcd_barrier_complete(bar, b.x, nloc, nx); b.st[0] = nloc; b.st[1] = nx; }
        const unsigned old = xb_add(&bar[XB_XSUB(b.x)], 1u);
        const unsigned gen = old / nloc;
        if (old + 1u == (gen + 1u) * nloc) {
            __builtin_amdgcn_fence(__ATOMIC_RELEASE, "agent");
            asm volatile("s_waitcnt vmcnt(0)" ::: "memory");
            const unsigned og = xb_add(&bar[XB_TOP], 1u);
            const unsigned tg = og / nx;
            if (og + 1u == (tg + 1u) * nx) xb_add(&bar[XB_TOPGEN], 1u);
            else XB_SPIN(xb_ld(&bar[XB_TOPGEN]) == tg, bar);
            __builtin_amdgcn_fence(__ATOMIC_ACQUIRE, "agent");
            xb_add(&bar[XB_XGEN(b.x)], 1u);
            asm volatile("s_waitcnt vmcnt(0)" ::: "memory");
        } else {
            XB_SPIN(xb_ld(&bar[XB_XGEN(b.x)]) == gen, bar);
            __builtin_amdgcn_fence(__ATOMIC_ACQUIRE, "agent");
            asm volatile("s_waitcnt vmcnt(0)" ::: "memory");
        }
    }
    __syncthreads();
}

constexpr int NPHASES = 20;
#ifndef PH_MASK
#define PH_MASK 0xFFFF
#endif
#define PHON(i) (((PH_MASK) >> (i)) & 1)
template <int PH> DI void run_phase(const Params& p, unsigned char* smem, PG8_LAS unsigned char* lds3, const int G) {
    const int bx = opaque_bid();
    float* MOD = (float*)(p.ws + WS_MOD); float* XC = (float*)(p.ws + WS_XC); bf16_t* H = (bf16_t*)(p.ws + WS_H);
    if constexpr (PH == 0) { phase_mod(p, smem); phase_convert<0>(p, 0, smem); }
    else if constexpr (PH == 1) { rowpass<0, true>(0, p.x, p.ctx, nullptr, nullptr, nullptr, nullptr, 0, nullptr, nullptr, p.g_pre_mix, MOD, 0, H); }
    else {
        constexpr int l = (PH - 2) / 9, k = (PH - 2) % 9;
        constexpr int rlo = l ? RC : 0;
        const float* xin_x = l ? p.out : p.x; const float* xin_c = l ? XC : p.ctx;
        const float* modl = MOD + (size_t)l * 9 * 6144;
        if constexpr (k == 0) {
            pg8::Gemm g{(const bf16_t*)H, (const bf16_t*)(p.ws + WS_WIN), RT, NIN, 1024, 1024}; pg8::StaticOrder S; S.init(RT, NIN, G, bx);
            EpiInProj E{(bf16_t*)(p.ws + WS_PA), (bf16_t*)(p.ws + WS_PQ), (bf16_t*)(p.ws + WS_PZ), (float*)(p.ws + WS_AB)};
            pg8::gemm_phase<EpiInProj, pg8::StaticOrder, false, true>(lds3, g, S, E);
        } else if constexpr (k == 1) { phase_gdn_pre(p, l, smem); }
        else if constexpr (k == 2) { if (bx < 64) phase_scan(p, l, smem); else if (G >= 256 && bx < 128) scan_helper(p, l, bx - 64); else if (G >= 256 && bx < 160) phase_convert<1>(p, l, smem, 128, 32); else { if (G < 256 && bx == 64) phase_convert<1>(p, l, smem, 64, 1); const int b0 = G >= 256 ? 160 : 64; phase_mix<0>(p, l, smem, b0, G - b0); } }
        else if constexpr (k == 3) { phase_mix<1>(p, l, smem, 0, G); }
        else if constexpr (k == 4) {
            {
                pg8::Gemm g{(const bf16_t*)(p.ws + WS_YMIX) + (size_t)RC * 1024, (const bf16_t*)(p.ws + WS_WO), RX, 1024, 1024, 1024}; pg8::StaticOrder S; S.init(RX, 1024, G, bx);
                EpiBf16Out E{(bf16_t*)(p.ws + WS_YO) + (size_t)RC * 1024, 1024};
                pg8::gemm_phase<EpiBf16Out, pg8::StaticOrder, false, true>(lds3, g, S, E); }
            if constexpr (l == 0) {
#pragma unroll 1
                for (int hk = 0; hk < 2; ++hk) {
                    pg8::Gemm g{(const bf16_t*)(p.ws + WS_YMIX) + hk * 512, (const bf16_t*)(p.ws + WS_WO) + hk * 512, RC, 1024, 512, 1024}; pg8::StaticOrder S; S.init(RC, 1024, G, (bx + G - 32 * hk) % G);
                    EpiBf16Out E{hk ? (bf16_t*)(p.ws + WS_CTXB) : (bf16_t*)(p.ws + WS_YO), 1024};
                    pg8::gemm_phase<EpiBf16Out, pg8::StaticOrder, false, true>(lds3, g, S, E); }
            }
        } else if constexpr (k == 5) {
            rowpass<1, true>(rlo, xin_x, xin_c, (const bf16_t*)(p.ws + WS_YO), l == 0 ? (const bf16_t*)(p.ws + WS_CTXB) : nullptr, p.g_post_mix + l * 1024, modl, 2, p.out, XC, p.g_pre_ffn + l * 1024, modl, 3, H);
        } else if constexpr (k == 6) {
            constexpr int M = RT - rlo;
            pg8::Gemm g{(const bf16_t*)H + (size_t)rlo * 1024, (const bf16_t*)(p.ws + WS_WF1), M, NF1, 1024, 1024}; pg8::StaticOrder S; S.init(M, NF1, G, bx);
            EpiSwiglu E{(bf16_t*)(p.ws + WS_HID) + (size_t)rlo * FH};
            pg8::gemm_phase<EpiSwiglu, pg8::StaticOrder, false, true>(lds3, g, S, E);
        } else if constexpr (k == 7) {
            {
                pg8::Gemm g{(const bf16_t*)(p.ws + WS_HID) + (size_t)RC * FH, (const bf16_t*)(p.ws + WS_WF2), RX, 1024, FH, FH}; pg8::StaticOrder S; S.init(RX, 1024, G, bx);
                EpiBf16Out E{(bf16_t*)(p.ws + WS_Y2) + (size_t)RC * 1024, 1024};
                pg8::gemm_phase<EpiBf16Out, pg8::StaticOrder, false, true>(lds3, g, S, E); }
            if constexpr (l == 0) {
#pragma unroll 1
                for (int hk = 0; hk < 2; ++hk) {
                    pg8::Gemm g{(const bf16_t*)(p.ws + WS_HID) + hk * (FH / 2), (const bf16_t*)(p.ws + WS_WF2) + hk * (FH / 2), RC, 1024, FH / 2, FH}; pg8::StaticOrder S; S.init(RC, 1024, G, (bx + G - 32 * hk) % G);
                    EpiBf16Out E{hk ? (bf16_t*)(p.ws + WS_CTXB) : (bf16_t*)(p.ws + WS_Y2), 1024};
                    pg8::gemm_phase<EpiBf16Out, pg8::StaticOrder, false, true>(lds3, g, S, E); }
            }
        } else {
            if constexpr (l == 0) { rowpass<1, true>(rlo, p.out, XC, (const bf16_t*)(p.ws + WS_Y2), (const bf16_t*)(p.ws + WS_CTXB), p.g_post_ffn, modl, 5, p.out, XC, p.g_pre_mix + 1024, MOD + (size_t)9 * 6144, 0, H); phase_convert<0>(p, 1, smem); }
            else rowpass<1, false>(rlo, p.out, XC, (const bf16_t*)(p.ws + WS_Y2), nullptr, p.g_post_ffn + 1024, modl, 5, p.out, XC, nullptr, nullptr, 0, nullptr);
        }
    }
}
template <int PH> DI void run_from(const Params& p, unsigned char* smem, PG8_LAS unsigned char* lds3, const int G, const XcdBarrier& xbar, cg::grid_group& grid) {
    run_phase<PH>(p, smem, lds3, G);
    if constexpr (PH + 1 < NPHASES) {
        if (PH == 0 && p.ph_lo < 0) grid.sync(); else xcd_barrier(xbar);
        run_from<PH + 1>(p, smem, lds3, G, xbar, grid);
    }
}
__global__ void __launch_bounds__(512) mega_fwd(Params p) {
    extern __shared__ __attribute__((aligned(16))) unsigned char smem[];
    cg::grid_group grid = cg::this_grid();
    volatile LAS unsigned* bst = (volatile LAS unsigned*)((LAS unsigned char*)smem + (LDS_BYTES - 64));
    if (threadIdx.x < 2) bst[threadIdx.x] = 0u;
    __syncthreads();
    const XcdBarrier xbar = xcd_barrier_post((unsigned*)(p.ws + WS_BAR), bst);
    run_from<0>(p, smem, (PG8_LAS unsigned char*)smem, (int)gridDim.x, xbar, grid);
}

extern "C" void kernel_launch(void* const* d_in, const int* in_sizes, int n_in, void* d_out, int out_size, void* d_ws, size_t ws_size, hipStream_t stream) {
    static int grid = 0;
    if (grid == 0) {
        if (n_in != 23 || ws_size < WS_END) { fprintf(stderr, "kernel_launch: unexpected inputs (n_in %d) or workspace too small (%zu < %zu)\n", n_in, ws_size, (size_t)WS_END); grid = -1; return; }
        int dev = 0, cus = 0, per_cu = 0;
        (void)hipGetDevice(&dev);
        (void)hipDeviceGetAttribute(&cus, hipDeviceAttributeMultiprocessorCount, dev);
        if (hipFuncSetAttribute((const void*)mega_fwd, hipFuncAttributeMaxDynamicSharedMemorySize, LDS_BYTES) != hipSuccess) { fprintf(stderr, "kernel_launch: hipFuncSetAttribute failed\n"); grid = -1; return; }
        if (hipOccupancyMaxActiveBlocksPerMultiprocessor(&per_cu, (const void*)mega_fwd, 512, LDS_BYTES) != hipSuccess || per_cu < 1) { per_cu = 1; (void)hipGetLastError(); }
        if (cus <= 0) cus = 256;
        grid = cus * per_cu;
    }
    if (grid < 0) return;
    Params p{};
    const float** pp = (const float**)&p;
    for (int i = 0; i < 23; ++i) pp[i] = (const float*)d_in[i];
    p.out = (float*)d_out; p.ws = (unsigned char*)d_ws; p.ph_lo = 0; p.ph_hi = NPHASES;
    (void)hipMemsetAsync((char*)d_ws + WS_BAR, 0, 16384, stream);
    void* args[] = {&p};
    hipError_t e = hipLaunchCooperativeKernel((const void*)mega_fwd, dim3(grid), dim3(512), args, LDS_BYTES, stream);
    if (e != hipSuccess) fprintf(stderr, "cooperative launch failed: %s (grid %d)\n", hipGetErrorString(e), grid);
}
```

```cpp
#include <hip/hip_runtime.h>
#include <hip/hip_cooperative_groups.h>
#include <cstdio>
#include <cstdint>
namespace cg = cooperative_groups;

__device__ __forceinline__ int opaque_tid() { int t = threadIdx.x; asm volatile("" : "+v"(t)); return t; }
__device__ __forceinline__ int opaque_bid() { int t = blockIdx.x; asm volatile("" : "+s"(t)); return t; }
namespace pg8 {
#define PG8_LAS __attribute__((address_space(3)))
typedef unsigned short bf16_t;
typedef short bf16x8 __attribute__((ext_vector_type(8)));
typedef float f32x4 __attribute__((ext_vector_type(4)));
typedef unsigned u32x4 __attribute__((ext_vector_type(4)));
constexpr int BM = 256, BK = 64, HALF = 128, HTB = HALF * BK * 2  , STAGE_BYTES = 8 * HTB, NXCD = 8, WGM = 8;

__host__ __device__ __forceinline__ int lds_byte(int r, int c) { const int st = (r >> 4) * 2 + (c >> 5), rr = r & 15, cc = c & 31, ob = rr * 64 + cc * 2; return st * 1024 + (ob ^ (((ob >> 9) & 1) << 5)); }
__host__ __device__ __forceinline__ void stage_rc(int b, int& R, int& C) { const int st = b / 1024, sb = b % 1024, swz = sb ^ (((sb >> 9) & 1) << 5); R = (st >> 1) * 16 + swz / 64; C = (st & 1) * 32 + (swz % 64) / 2; }
__host__ __device__ __forceinline__ int perm32(int rho) { const int n = rho >> 4, i = rho & 15; return 8 * (i >> 2) + 4 * n + (i & 3); }

struct Unit { int pm, pn; };
struct Gemm { const bf16_t* A; const bf16_t* Bt; int M, N, K, ld; };

struct StaticOrder {
    int nM, nN, nwg, G, c;
    __host__ __device__ void init(int M, int N, int G_, int c_) { nM = M / BM; nN = N / BM; nwg = nM * nN; G = G_; c = c_; }
    __host__ __device__ bool next(int i, Unit& u) const {
        const long L = (long)i * G + c; if (L >= nwg) return false;
        int wgid = (int)L; { const int q = nwg / NXCD, r = nwg % NXCD, xcd = wgid % NXCD, off = wgid / NXCD; wgid = (xcd < r ? xcd * (q + 1) : r * (q + 1) + (xcd - r) * q) + off; }
        const int nig = WGM * nN, gid = wgid / nig, fm = gid * WGM, gsz = (nM - fm) < WGM ? (nM - fm) : WGM;
        u.pm = fm + ((wgid % nig) % gsz); u.pn = (wgid % nig) / gsz; return true;
    }
    __device__ __forceinline__ void a_ready(const Unit&) const {}
    __device__ __forceinline__ void done(const Unit&) const {}
};

template <class Epi, class Sched, bool ALIGN_EPI = false, bool SP2 = false>
__device__ __forceinline__ void gemm_phase(PG8_LAS unsigned char* lds, const Gemm g, const Sched& S, const Epi& E) {
    const int tid = opaque_tid(), wid = __builtin_amdgcn_readfirstlane(tid >> 6), lane = tid & 63, wr = wid >> 2, wc = wid & 3, fr = lane & 15, fq = lane >> 4;
    const int K = g.ld, nt = g.K / BK;
    unsigned voffA[2], voffB[2];
#pragma unroll
    for (int i = 0; i < 2; ++i) { int R, C; stage_rc(tid * 16 + i * 8192, R, C); const int Rb = Epi::PERM ? ((R & ~31) + perm32(R & 31)) : R;
        voffA[i] = (unsigned)(R * K + C) * 2u; voffB[i] = (unsigned)(Rb * K + C) * 2u; }
    const size_t kstep = (size_t)(BK * 2);
    const size_t hstep = (size_t)HALF * K * 2;
    const size_t tstep = 2 * hstep;
    const unsigned ldsw = (unsigned)wid * 1024u;
    const int aoff = lds_byte(wr * 64 + fr, fq * 8), boff = lds_byte(wc * 32 + fr, fq * 8);
#define PG8_SA(b, h) (((b) * 2 + (h)) * HTB)
#define PG8_SB(b, h) ((4 + (b) * 2 + (h)) * HTB)
#define PG8_STAGE(bufoff, gbase, voff) do { _Pragma("unroll") for (int _i = 0; _i < 2; ++_i) \
        __builtin_amdgcn_global_load_lds((const unsigned*)((const char*)(gbase) + (voff)[_i]), (PG8_LAS unsigned*)(lds + (bufoff) + ldsw + _i * 8192), 16, 0, 0); } while (0)
#define PG8_LDA(dst, b, h) do { _Pragma("unroll") for (int m = 0; m < 4; ++m) _Pragma("unroll") for (int k = 0; k < 2; ++k) dst[m][k] = *(const PG8_LAS bf16x8*)(lds + PG8_SA(b, h) + aoff + m * 2048 + k * 1024); } while (0)
#define PG8_LDB(dst, b, h) do { _Pragma("unroll") for (int n = 0; n < 2; ++n) _Pragma("unroll") for (int k = 0; k < 2; ++k) dst[n][k] = *(const PG8_LAS bf16x8*)(lds + PG8_SB(b, h) + boff + n * 2048 + k * 1024); } while (0)
#define PG8_MMA(ai, bj, At, Bt) do { __builtin_amdgcn_s_setprio(1); _Pragma("unroll") for (int m = 0; m < 4; ++m) _Pragma("unroll") for (int n = 0; n < 2; ++n) _Pragma("unroll") for (int k = 0; k < 2; ++k) \
        acc[ai][bj][m][n] = __builtin_amdgcn_mfma_f32_16x16x32_bf16(Bt[n][k], At[m][k], acc[ai][bj][m][n], 0, 0, 0); __builtin_amdgcn_s_setprio(0); } while (0)
#define PG8_WAIT_V(n) asm volatile("s_waitcnt vmcnt(" #n ")" ::: "memory")
#define PG8_WAIT_L(n) asm volatile("s_waitcnt lgkmcnt(" #n ")" ::: "memory")
#define PG8_BAR __builtin_amdgcn_s_barrier()
#define PG8_SCHED __builtin_amdgcn_sched_barrier(0)
    Unit cur, nxt; int ui = 0;
    if (!S.next(0, cur)) return;
    f32x4 acc[2][2][4][2];
#pragma unroll
    for (int a = 0; a < 2; ++a)
#pragma unroll
        for (int b = 0; b < 2; ++b)
#pragma unroll
            for (int m = 0; m < 4; ++m)
#pragma unroll
                for (int n = 0; n < 2; ++n) acc[a][b][m][n] = (f32x4){0.f, 0.f, 0.f, 0.f};
    bf16x8 At[4][2], B0[2][2], B1[2][2];
    const char* cA = (const char*)g.A + (size_t)cur.pm * tstep; const char* cB = (const char*)g.Bt + (size_t)cur.pn * tstep;
    S.a_ready(cur);
    if constexpr (SP2) {
        PG8_STAGE(PG8_SB(0, 0), cB, voffB); PG8_STAGE(PG8_SB(0, 1), cB + hstep, voffB); PG8_STAGE(PG8_SA(0, 0), cA, voffA); PG8_STAGE(PG8_SA(0, 1), cA + hstep, voffA);
        if (wr == 1) PG8_BAR;
        PG8_WAIT_V(2); PG8_BAR;
        PG8_STAGE(PG8_SB(1, 0), cB + kstep, voffB); PG8_STAGE(PG8_SA(1, 0), cA + kstep, voffA); PG8_STAGE(PG8_SB(1, 1), cB + hstep + kstep, voffB);
        PG8_WAIT_V(6); PG8_BAR;
    } else {
        PG8_STAGE(PG8_SB(0, 0), cB, voffB); PG8_STAGE(PG8_SA(0, 0), cA, voffA); PG8_STAGE(PG8_SB(0, 1), cB + hstep, voffB); PG8_STAGE(PG8_SA(0, 1), cA + hstep, voffA);
        if (wr == 1) PG8_BAR;
        PG8_WAIT_V(4); PG8_BAR;
        PG8_STAGE(PG8_SB(1, 0), cB + kstep, voffB); PG8_STAGE(PG8_SA(1, 0), cA + kstep, voffA); PG8_STAGE(PG8_SB(1, 1), cB + hstep + kstep, voffB);
        PG8_WAIT_V(6); PG8_BAR;
    }
    for (;;) {
        const bool has_next = S.next(ui + 1, nxt);
        const char* nA = has_next ? (const char*)g.A + (size_t)nxt.pm * tstep : cA; const char* nB = has_next ? (const char*)g.Bt + (size_t)nxt.pn * tstep : cB;
        for (int t = 0; t < nt; t += 2) {
            const bool last = (t == nt - 2);
            const char* a1 = cA + (size_t)(t + 1) * kstep;
            const char* a2 = last ? nA : cA + (size_t)(t + 2) * kstep; const char* b2 = last ? nB : cB + (size_t)(t + 2) * kstep;
            const char* a3 = a2 + kstep; const char* b3 = b2 + kstep;
            if (last && has_next) S.a_ready(nxt);
            if constexpr (SP2) {
            PG8_LDB(B0, 0, 0); PG8_LDB(B1, 0, 1); PG8_SCHED; PG8_LDA(At, 0, 0); PG8_STAGE(PG8_SA(1, 1), a1 + hstep, voffA);
            PG8_WAIT_V(8); PG8_WAIT_L(0); PG8_BAR; PG8_MMA(0, 0, At, B0); PG8_MMA(0, 1, At, B1); PG8_BAR; PG8_SCHED;
            PG8_LDA(At, 0, 1); PG8_STAGE(PG8_SB(0, 0), b2, voffB); PG8_STAGE(PG8_SB(0, 1), b2 + hstep, voffB); PG8_STAGE(PG8_SA(0, 0), a2, voffA);
            PG8_WAIT_V(8); PG8_WAIT_L(0); PG8_BAR; PG8_MMA(1, 0, At, B0); PG8_MMA(1, 1, At, B1); PG8_BAR; PG8_SCHED;
            PG8_LDB(B0, 1, 0); PG8_LDB(B1, 1, 1); PG8_SCHED; PG8_LDA(At, 1, 0); PG8_STAGE(PG8_SA(0, 1), a2 + hstep, voffA);
            PG8_WAIT_V(8); PG8_WAIT_L(0); PG8_BAR; PG8_MMA(0, 0, At, B0); PG8_MMA(0, 1, At, B1); PG8_BAR; PG8_SCHED;
            PG8_LDA(At, 1, 1); PG8_STAGE(PG8_SB(1, 0), b3, voffB); PG8_STAGE(PG8_SB(1, 1), b3 + hstep, voffB); PG8_STAGE(PG8_SA(1, 0), a3, voffA);
            PG8_WAIT_V(8); PG8_WAIT_L(0); PG8_BAR; PG8_MMA(1, 0, At, B0); PG8_MMA(1, 1, At, B1); PG8_BAR; PG8_SCHED;
            } else {
            PG8_LDB(B0, 0, 0); PG8_SCHED; PG8_LDA(At, 0, 0); PG8_STAGE(PG8_SA(1, 1), a1 + hstep, voffA);
            PG8_WAIT_L(8); PG8_BAR; PG8_WAIT_L(0); PG8_MMA(0, 0, At, B0); PG8_BAR; PG8_SCHED;
            PG8_LDB(B1, 0, 1); PG8_STAGE(PG8_SB(0, 0), b2, voffB);
            PG8_BAR; PG8_WAIT_L(0); PG8_MMA(0, 1, At, B1); PG8_BAR;
            PG8_LDA(At, 0, 1); PG8_STAGE(PG8_SA(0, 0), a2, voffA);
            PG8_BAR; PG8_WAIT_L(0); PG8_MMA(1, 0, At, B0); PG8_BAR; PG8_SCHED;
            PG8_STAGE(PG8_SB(0, 1), b2 + hstep, voffB);
            PG8_WAIT_V(6); PG8_BAR; PG8_MMA(1, 1, At, B1); PG8_BAR;
            PG8_LDB(B0, 1, 0); PG8_SCHED; PG8_LDA(At, 1, 0); PG8_STAGE(PG8_SA(0, 1), a2 + hstep, voffA);
            PG8_WAIT_L(8); PG8_BAR; PG8_WAIT_L(0); PG8_MMA(0, 0, At, B0); PG8_BAR; PG8_SCHED;
            PG8_LDB(B1, 1, 1); PG8_STAGE(PG8_SB(1, 0), b3, voffB);
            PG8_BAR; PG8_WAIT_L(0); PG8_MMA(0, 1, At, B1); PG8_BAR;
            PG8_LDA(At, 1, 1); PG8_STAGE(PG8_SA(1, 0), a3, voffA);
            PG8_BAR; PG8_WAIT_L(0); PG8_MMA(1, 0, At, B0); PG8_BAR; PG8_SCHED;
            PG8_STAGE(PG8_SB(1, 1), b3 + hstep, voffB);
            PG8_WAIT_V(6); PG8_BAR; PG8_MMA(1, 1, At, B1); PG8_BAR;
            }
        }
        if constexpr (ALIGN_EPI) { if (wr == 0) PG8_BAR; }
        if constexpr (!Epi::AFTER_DRAIN) { E(acc, cur, wr, wc, fr, fq); S.done(cur); }
        if (!has_next) break;
#pragma unroll
        for (int a = 0; a < 2; ++a)
#pragma unroll
            for (int b = 0; b < 2; ++b)
#pragma unroll
                for (int m = 0; m < 4; ++m)
#pragma unroll
                    for (int n = 0; n < 2; ++n) acc[a][b][m][n] = (f32x4){0.f, 0.f, 0.f, 0.f};
        cur = nxt; cA = nA; cB = nB; ++ui;
        if constexpr (ALIGN_EPI) { if (wr == 1) PG8_BAR; }
    }
    PG8_WAIT_V(0);
    if constexpr (!ALIGN_EPI) { if (wr == 0) PG8_BAR; }
    PG8_BAR;
    if constexpr (Epi::AFTER_DRAIN) { E.fused(acc, cur, wr, wc, fr, fq, lds, wid, lane); S.done(cur); }
#undef PG8_SA
#undef PG8_SB
#undef PG8_STAGE
#undef PG8_LDA
#undef PG8_LDB
#undef PG8_MMA
#undef PG8_WAIT_V
#undef PG8_WAIT_L
#undef PG8_BAR
#undef PG8_SCHED
}
}

#define DI __device__ __forceinline__
typedef unsigned short bf16_t;
typedef short bf16x8 __attribute__((ext_vector_type(8)));
typedef float f32x2 __attribute__((ext_vector_type(2)));
typedef float f32x4 __attribute__((ext_vector_type(4)));
typedef float f32x16 __attribute__((ext_vector_type(16)));
typedef unsigned u32x2 __attribute__((ext_vector_type(2)));
typedef unsigned u32x4 __attribute__((ext_vector_type(4)));
typedef __bf16 bf16x2_t __attribute__((ext_vector_type(2)));

constexpr int DM = 1024, NB = 8, SEQL = 4096, CTXL = 256;
constexpr int RC = NB * CTXL, RX = NB * SEQL, RT = RC + RX;
constexpr int INC = 3344, NIN = 3584, FH = 2816, NF1 = 5632;
constexpr float EPSV = 1e-6f;
constexpr int LDS_BYTES = 155648;

constexpr size_t WS_WIN = 0;
constexpr size_t WS_WO  = WS_WIN + (size_t)NIN * 1024 * 2;
constexpr size_t WS_WF1 = WS_WO + (size_t)1024 * 1024 * 2;
constexpr size_t WS_WF2 = WS_WF1 + (size_t)NF1 * 1024 * 2;
constexpr size_t WS_MOD = WS_WF2 + (size_t)1024 * FH * 2;
constexpr size_t WS_XC  = WS_MOD + (size_t)2 * 9 * 6144 * 4;
constexpr size_t WS_AB  = WS_XC + (size_t)RC * 1024 * 4;
constexpr size_t WS_PA  = WS_AB + (size_t)RT * 16 * 4;
constexpr size_t WS_PQ  = WS_PA + (size_t)RT * 768 * 2;
constexpr size_t WS_PZ  = WS_PQ + (size_t)RT * 1536 * 2;
constexpr size_t WS_G   = WS_PZ + (size_t)RT * 1024 * 2;
constexpr int    UNIT_BYTES = 116736;
constexpr int    NUNITS = 544 * 4;
constexpr size_t WS_BAR = WS_G + (size_t)NUNITS * UNIT_BYTES;
constexpr size_t WS_CTXB = WS_BAR + 16384;
constexpr size_t WS_END = WS_CTXB + (size_t)RC * 1024 * 2;
constexpr size_t WS_H    = WS_G;
constexpr size_t WS_YMIX = WS_G + (size_t)RT * 1024 * 2;
constexpr size_t WS_Y2   = WS_G + (size_t)RT * 1024 * 2;
constexpr size_t WS_YO   = WS_PA;
constexpr size_t WS_HID  = WS_PA;
constexpr size_t WS_OF   = WS_PQ;
constexpr size_t WS_OB   = WS_PQ + (size_t)RT * 512 * 2;
constexpr size_t WS_YAC  = WS_PQ + (size_t)RT * 1024 * 2;
static_assert(WS_Y2 + (size_t)RT * 1024 * 4 <= WS_END, "Y2 overlay");
static_assert(WS_HID + (size_t)RT * FH * 2 <= WS_G, "HID overlay");
constexpr int OFF_Q = 0, OFF_KT = 16384, OFF_D0 = 32768, DIR_BYTES = 40960, OFF_W = 0, OFF_QK = 16384, OFF_U = 24576, OFF_SC = 114688, SC_BYTES = 528;
constexpr int SCAN_BUF = 74752;

struct Params {
    const float *x, *c, *ctx, *c_ctx, *w_mod, *b_mod, *g_pre_mix, *g_post_mix, *g_pre_ffn, *g_post_ffn, *w_in, *conv_a, *conv_qkv, *a_log, *dt_bias,
                *g_onorm, *ln_c_g, *ln_c_b, *w_s, *b_s, *w_o, *w_ffn_in, *w_ffn_out;
    float* out; unsigned char* ws;
    int ph_lo, ph_hi;
};

DI unsigned pkbf(float lo, float hi) { f32x2 v = {lo, hi}; return __builtin_bit_cast(unsigned, __builtin_convertvector(v, bf16x2_t)); }
DI bf16_t bf1(float x) { return (bf16_t)(pkbf(x, 0.f) & 0xffffu); }
DI float bflo(unsigned w) { return __uint_as_float(w << 16); }
DI float bfhi(unsigned w) { return __uint_as_float(w & 0xffff0000u); }
DI float bf2f(bf16_t b) { return __uint_as_float(((unsigned)b) << 16); }
DI void unpack8(const u32x4 w, float* o) { o[0] = bflo(w.x); o[1] = bfhi(w.x); o[2] = bflo(w.y); o[3] = bfhi(w.y); o[4] = bflo(w.z); o[5] = bfhi(w.z); o[6] = bflo(w.w); o[7] = bfhi(w.w); }
DI u32x4 packw8(const float* v) { u32x4 w; w.x = pkbf(v[0], v[1]); w.y = pkbf(v[2], v[3]); w.z = pkbf(v[4], v[5]); w.w = pkbf(v[6], v[7]); return w; }
DI bf16x8 pack16s(const f32x16& x, const int s) {
    u32x4 w;
    if (s == 0) { w.x = pkbf(x[0], x[1]); w.y = pkbf(x[2], x[3]); w.z = pkbf(x[4], x[5]); w.w = pkbf(x[6], x[7]); }
    else        { w.x = pkbf(x[8], x[9]); w.y = pkbf(x[10], x[11]); w.z = pkbf(x[12], x[13]); w.w = pkbf(x[14], x[15]); }
    return __builtin_bit_cast(bf16x8, w);
}
#define MFMA32(a, b, c) __builtin_amdgcn_mfma_f32_32x32x16_bf16((a), (b), (c), 0, 0, 0)
DI int crow(int reg, int h) { return (reg & 3) + 8 * (reg >> 2) + 4 * h; }
DI float wave_sum(float v) {
#pragma unroll
    for (int o = 1; o < 64; o <<= 1) v += __shfl_xor(v, o);
    return v;
}
DI float siluf(float x) { return x / (1.f + expf(-x)); }
DI float sigmf(float x) { return 1.f / (1.f + expf(-x)); }
DI float geluf(float x) { return 0.5f * x * (1.f + erff(x * 0.70710678118654752f)); }
DI float fsilu(float x) { return x * __builtin_amdgcn_rcpf(1.f + __expf(-x)); }
DI float fgelu(float v) {
    const float av = fabsf(v), t = __builtin_amdgcn_rcpf(av * 0.2316418882f + 1.0f);
    float q = t * 0.5307027145f + (-0.7265760135f); q = q * t + 0.7107068705f; q = q * t + (-0.142248368f); q = q * t + 0.127414796f; q = q * t;
    const float e = __builtin_amdgcn_exp2f((v * v) * (-0.72134752044f));
    const float m = v * (q * e);
    return v < 0.f ? m : v - m;
}
DI float softplusf(float x) { return x > 20.f ? x : log1pf(expf(x)); }
#define LDS_WAIT() asm volatile("s_waitcnt lgkmcnt(0)" ::: "memory")
#define LBAR() asm volatile("s_waitcnt lgkmcnt(0)\n\ts_barrier" ::: "memory")

struct EpiBf16Out {
    static constexpr bool PERM = true, AFTER_DRAIN = false;
    bf16_t* out; int ldc;
    DI void operator()(const pg8::f32x4 (&acc)[2][2][4][2], const pg8::Unit& u, int wr, int wc, int fr, int fq) const {
        const int row0 = u.pm * 256 + wr * 64 + fr, col0 = u.pn * 256 + wc * 32 + 8 * fq;
#pragma unroll
        for (int ai = 0; ai < 2; ++ai)
#pragma unroll
            for (int m = 0; m < 4; ++m) { bf16_t* rp = out + (size_t)(row0 + ai * 128 + m * 16) * ldc + col0;
#pragma unroll
                for (int bj = 0; bj < 2; ++bj) { const pg8::f32x4 v0 = acc[ai][bj][m][0], v1 = acc[ai][bj][m][1];
                    u32x4 w; w.x = pkbf(v0[0], v0[1]); w.y = pkbf(v0[2], v0[3]); w.z = pkbf(v1[0], v1[1]); w.w = pkbf(v1[2], v1[3]);
                    *(u32x4*)(rp + bj * 128) = w; } }
    }
};
struct EpiInProj {
    static constexpr bool PERM = true, AFTER_DRAIN = false;
    bf16_t *PA, *PQ, *PZ; float* AB;
    DI void operator()(const pg8::f32x4 (&acc)[2][2][4][2], const pg8::Unit& u, int wr, int wc, int fr, int fq) const {
        const int row0 = u.pm * 256 + wr * 64 + fr;
        if (u.pn == 13) {
            if (wc == 0 && fq < 2) {
#pragma unroll
                for (int ai = 0; ai < 2; ++ai)
#pragma unroll
                    for (int m = 0; m < 4; ++m)
#pragma unroll
                        for (int n = 0; n < 2; ++n) *(pg8::f32x4*)(AB + (size_t)(row0 + ai * 128 + m * 16) * 16 + 8 * fq + 4 * n) = acc[ai][0][m][n];
            }
            return;
        }
        bf16_t* base; int ldc, coff;
        if (u.pn < 3) { base = PA; ldc = 768; coff = 256 * u.pn; }
        else if (u.pn < 9) { base = PQ; ldc = 1536; coff = 256 * (u.pn - 3); }
        else { base = PZ; ldc = 1024; coff = 256 * (u.pn - 9); }
        const int col0 = coff + wc * 32 + 8 * fq;
#pragma unroll
        for (int ai = 0; ai < 2; ++ai)
#pragma unroll
            for (int m = 0; m < 4; ++m) { bf16_t* rp = base + (size_t)(row0 + ai * 128 + m * 16) * ldc + col0;
#pragma unroll
                for (int bj = 0; bj < 2; ++bj) { const pg8::f32x4 v0 = acc[ai][bj][m][0], v1 = acc[ai][bj][m][1];
                    u32x4 w; w.x = pkbf(v0[0], v0[1]); w.y = pkbf(v0[2], v0[3]); w.z = pkbf(v1[0], v1[1]); w.w = pkbf(v1[2], v1[3]);
                    *(u32x4*)(rp + bj * 128) = w; } }
    }
};
struct EpiSwiglu {
    static constexpr bool PERM = true, AFTER_DRAIN = false;
    bf16_t* hid;
    DI void operator()(const pg8::f32x4 (&acc)[2][2][4][2], const pg8::Unit& u, int wr, int wc, int fr, int fq) const {
        const int row0 = u.pm * 256 + wr * 64 + fr, col0 = u.pn * 128 + wc * 32 + 8 * fq;
#pragma unroll
        for (int ai = 0; ai < 2; ++ai)
#pragma unroll
            for (int m = 0; m < 4; ++m) {
                float o[8];
#pragma unroll
                for (int n = 0; n < 2; ++n)
#pragma unroll
                    for (int j = 0; j < 4; ++j) { const float g = acc[ai][0][m][n][j], uu = acc[ai][1][m][n][j]; o[4 * n + j] = fsilu(g) * uu; }
                *(u32x4*)(hid + (size_t)(row0 + ai * 128 + m * 16) * FH + col0) = packw8(o);
            }
    }
};

DI void phase_mod(const Params& p, unsigned char* lds) {
    float* sc = (float*)lds;
    float* red = sc + 9 * 1024;
    float* MOD = (float*)(p.ws + WS_MOD);
    const int tid = opaque_tid();
    for (int it = opaque_bid(); it < 192; it += gridDim.x) {
        for (int i = tid; i < 9 * 1024; i += 512) { const int s = i >> 10, k = i & 1023; const float v = (s < 8) ? p.c[s * 1024 + k] : p.c_ctx[k]; sc[i] = siluf(v); }
        __syncthreads();
        const int l = it / 96, n0 = (it % 96) * 64, nn = tid & 63, kg = tid >> 6;
        const float* w = p.w_mod + ((size_t)l * 1024 + kg * 128) * 6144 + n0 + nn;
        float a[9];
#pragma unroll
        for (int s = 0; s < 9; ++s) a[s] = 0.f;
#pragma unroll 32
        for (int k = 0; k < 128; ++k) { const float wv = __builtin_nontemporal_load(w + (size_t)k * 6144);
#pragma unroll
            for (int s = 0; s < 9; ++s) a[s] += sc[s * 1024 + kg * 128 + k] * wv; }
#pragma unroll
        for (int s = 0; s < 9; ++s) red[(kg * 9 + s) * 64 + nn] = a[s];
        __syncthreads();
        for (int i = tid; i < 576; i += 512) { const int s = i >> 6, n2 = i & 63; float v = p.b_mod[l * 6144 + n0 + n2];
#pragma unroll
            for (int k2 = 0; k2 < 8; ++k2) v += red[(k2 * 9 + s) * 64 + n2];
            MOD[(size_t)(l * 9 + s) * 6144 + n0 + n2] = v; }
        __syncthreads();
    }
}
template <int MAP> DI int rowmap(int n) {
    if (MAP == 1) return n < 2304 ? n : (n < 2320 ? 3328 + (n - 2304) : n - 16);
    if (MAP == 2) { if (n < FH) return 256 * (n >> 7) + (n & 127); const int m = n - FH; return 256 * (m >> 7) + 128 + (m & 127); }
    return n;
}
template <int MAP> DI void tr_item(const float* W, int K, int N, bf16_t* WT, float* scr, int item, int lane) {
    const int nblk = (N + 31) / 32, kb = item / nblk, nb = item % nblk, k0 = 64 * kb, n0 = 32 * nb;
    const int nl = n0 + (lane & 31);
    float tv[32];
#pragma unroll
    for (int i = 0; i < 32; ++i) { const int kk = 2 * i + (lane >> 5); tv[i] = nl < N ? __builtin_nontemporal_load(W + (size_t)(k0 + kk) * N + nl) : 0.f; }
#pragma unroll
    for (int i = 0; i < 32; ++i) { const int kk = 2 * i + (lane >> 5); scr[kk * 33 + (lane & 31)] = tv[i]; }
    LDS_WAIT();
    const int c8 = lane & 7;
#pragma unroll
    for (int j = 0; j < 4; ++j) { const int n = (lane >> 3) + 8 * j; const float* s = scr + (8 * c8) * 33 + n;
        u32x4 o; o.x = pkbf(s[0], s[33]); o.y = pkbf(s[66], s[99]); o.z = pkbf(s[132], s[165]); o.w = pkbf(s[198], s[231]);
        if (n0 + n < N) *(u32x4*)(WT + (size_t)rowmap<MAP>(n0 + n) * K + k0 + 8 * c8) = o; }
    LDS_WAIT();
}
template <int PART> DI void phase_convert(const Params& p, int l, unsigned char* lds, int b0 = 0, int nb = 0) {
    const int tid = opaque_tid(), lane = tid & 63, wave = tid >> 6;
    float* scr = (float*)(lds + 65536) + wave * (64 * 33);
    bf16_t* WIN = (bf16_t*)(p.ws + WS_WIN); bf16_t* WO = (bf16_t*)(p.ws + WS_WO); bf16_t* WF1 = (bf16_t*)(p.ws + WS_WF1); bf16_t* WF2 = (bf16_t*)(p.ws + WS_WF2);
    constexpr int I_IN = 16 * 105, I_O = 16 * 32, I_F1 = 16 * 176, I_F2 = 44 * 32, NIT = I_IN + I_O + I_F1 + I_F2;
    const int gw = (PART == 0 ? opaque_bid() : opaque_bid() - b0) * 8 + wave, NGW = (PART == 0 ? (int)gridDim.x : nb) * 8;
    for (int it = (PART == 0 ? 0 : I_IN) + gw; it < (PART == 0 ? I_IN : NIT); it += NGW) {
        int r = it;
        if (r < I_IN) { tr_item<1>(p.w_in + (size_t)l * 1024 * INC, 1024, INC, WIN, scr, r, lane); continue; } r -= I_IN;
        if (r < I_O) { tr_item<0>(p.w_o + (size_t)l * 1024 * 1024, 1024, 1024, WO, scr, r, lane); continue; } r -= I_O;
        if (r < I_F1) { tr_item<2>(p.w_ffn_in + (size_t)l * 1024 * NF1, 1024, NF1, WF1, scr, r, lane); continue; } r -= I_F1;
        tr_item<0>(p.w_ffn_out + (size_t)l * FH * 1024, FH, 1024, WF2, scr, r, lane);
    }
    if (PART == 0) {
        u32x4* z = (u32x4*)(WIN + (size_t)INC * 1024);
        unsigned zz = 0u; asm volatile("" : "+v"(zz));
        const u32x4 zero = {zz, zz, zz, zz};
        for (int i = opaque_bid() * 512 + tid; i < (NIN - INC) * 1024 / 8; i += gridDim.x * 512) z[i] = zero;
    }
}

template <int MODE, bool WRITE_H> DI void rowpass(int row_lo, const float* xin_x, const float* xin_c, const bf16_t* Y, const bf16_t* Yb, const float* g_post, const float* mod_gate, int gate_idx,
                                    float* xout_x, float* xout_c, const float* g_pre, const float* mod_h, int shift_idx, bf16_t* H) {
    const int tid = opaque_tid(), lane = tid & 63, wave = tid >> 6;
    const int gw = opaque_bid() * 8 + wave, NGW = gridDim.x * 8;
    constexpr int NR = 4;
    for (int r0 = row_lo + gw * NR; r0 < RT; r0 += NGW * NR) {
        const int slot = r0 < RC ? 8 : ((r0 - RC) >> 12);
        const float* xr0 = r0 < RC ? xin_c + (size_t)r0 * 1024 : xin_x + (size_t)(r0 - RC) * 1024;
        f32x4 v[NR][4];
#pragma unroll
        for (int i = 0; i < NR; ++i)
#pragma unroll
            for (int j = 0; j < 4; ++j) v[i][j] = __builtin_nontemporal_load((const f32x4*)(xr0 + (size_t)i * 1024 + 4 * lane + 256 * j));
        u32x2 yw[NR][4]; f32x4 gp[4], gt[4], gpre[4], s1[4], s0[4];
        if (MODE == 1) {
            const float* gtp = mod_gate + (size_t)slot * 6144 + gate_idx * 1024;
#pragma unroll
            for (int i = 0; i < NR; ++i)
#pragma unroll
                for (int j = 0; j < 4; ++j) yw[i][j] = __builtin_nontemporal_load((const u32x2*)(Y + (size_t)(r0 + i) * 1024 + 4 * lane + 256 * j));
            if (Yb != nullptr && r0 < RC) {
                const bf16_t* Ybo = Yb; asm volatile("" : "+s"(Ybo));
#pragma unroll
                for (int i = 0; i < NR; ++i)
#pragma unroll
                    for (int j = 0; j < 4; ++j) { const u32x2 w2 = *(const u32x2*)(Ybo + (size_t)(r0 + i) * 1024 + 4 * lane + 256 * j);
                        yw[i][j].x = pkbf(bflo(yw[i][j].x) + bflo(w2.x), bfhi(yw[i][j].x) + bfhi(w2.x)); yw[i][j].y = pkbf(bflo(yw[i][j].y) + bflo(w2.y), bfhi(yw[i][j].y) + bfhi(w2.y)); }
            }
#pragma unroll
            for (int j = 0; j < 4; ++j) { gp[j] = *(const f32x4*)(g_post + 4 * lane + 256 * j); gt[j] = *(const f32x4*)(gtp + 4 * lane + 256 * j); }
        }
        if (WRITE_H) {
            const float* sh = mod_h + (size_t)slot * 6144 + shift_idx * 1024;
#pragma unroll
            for (int j = 0; j < 4; ++j) { gpre[j] = *(const f32x4*)(g_pre + 4 * lane + 256 * j); s0[j] = *(const f32x4*)(sh + 4 * lane + 256 * j); s1[j] = *(const f32x4*)(sh + 1024 + 4 * lane + 256 * j); }
        }
        if (MODE == 1) {
            float ss[NR];
#pragma unroll
            for (int i = 0; i < NR; ++i) { ss[i] = 0.f;
#pragma unroll
                for (int j = 0; j < 4; ++j) { const float a = bflo(yw[i][j].x), b2 = bfhi(yw[i][j].x), c2 = bflo(yw[i][j].y), d2 = bfhi(yw[i][j].y); ss[i] += (a * a + b2 * b2) + (c2 * c2 + d2 * d2); } }
#pragma unroll
            for (int o = 1; o < 64; o <<= 1) {
#pragma unroll
                for (int i = 0; i < NR; ++i) ss[i] += __shfl_xor(ss[i], o); }
            float* xo0 = r0 < RC ? xout_c + (size_t)r0 * 1024 : xout_x + (size_t)(r0 - RC) * 1024;
#pragma unroll
            for (int i = 0; i < NR; ++i) { const float rstd = rsqrtf(ss[i] * (1.f / 1024.f) + EPSV);
#pragma unroll
                for (int j = 0; j < 4; ++j) { const f32x4 y = {bflo(yw[i][j].x), bfhi(yw[i][j].x), bflo(yw[i][j].y), bfhi(yw[i][j].y)};
                    v[i][j] = v[i][j] + gt[j] * (y * rstd * gp[j]); __builtin_nontemporal_store(v[i][j], (f32x4*)(xo0 + (size_t)i * 1024 + 4 * lane + 256 * j)); } }
        }
        if (WRITE_H) {
            float ss[NR];
#pragma unroll
            for (int i = 0; i < NR; ++i) { ss[i] = 0.f;
#pragma unroll
                for (int j = 0; j < 4; ++j) ss[i] += (v[i][j].x * v[i][j].x + v[i][j].y * v[i][j].y) + (v[i][j].z * v[i][j].z + v[i][j].w * v[i][j].w); }
#pragma unroll
            for (int o = 1; o < 64; o <<= 1) {
#pragma unroll
                for (int i = 0; i < NR; ++i) ss[i] += __shfl_xor(ss[i], o); }
#pragma unroll
            for (int i = 0; i < NR; ++i) { const float rstd = rsqrtf(ss[i] * (1.f / 1024.f) + EPSV);
#pragma unroll
                for (int j = 0; j < 4; ++j) { const f32x4 hv = v[i][j] * rstd * gpre[j] * (1.f + s1[j]) + s0[j];
                    u32x2 w; w.x = pkbf(hv.x, hv.y); w.y = pkbf(hv.z, hv.w);
                    *(u32x2*)(H + (size_t)(r0 + i) * 1024 + 4 * lane + 256 * j) = w; } }
        }
    }
}
#ifndef STEP_MASK
#define STEP_MASK 0xFF
#endif
#define STEPON(i) (((STEP_MASK) >> (i)) & 1)
DI void conv_silu16(const u32x4* raw, const float* cw, float* out) {
#pragma unroll
    for (int hb = 0; hb < 2; ++hb) {
        float xc[8], xp[8], xn[8]; unpack8(raw[2 + hb], xc); unpack8(raw[hb], xp); unpack8(raw[4 + hb], xn);
        const f32x4 w0a = *(const f32x4*)(cw + 8 * hb), w0b = *(const f32x4*)(cw + 8 * hb + 4);
        const f32x4 w1a = *(const f32x4*)(cw + 1536 + 8 * hb), w1b = *(const f32x4*)(cw + 1536 + 8 * hb + 4);
        const f32x4 w2a = *(const f32x4*)(cw + 3072 + 8 * hb), w2b = *(const f32x4*)(cw + 3072 + 8 * hb + 4);
#pragma unroll
        for (int e = 0; e < 8; ++e) { const float w0 = e < 4 ? w0a[e & 3] : w0b[e & 3], w1 = e < 4 ? w1a[e & 3] : w1b[e & 3], w2 = e < 4 ? w2a[e & 3] : w2b[e & 3];
            out[8 * hb + e] = fsilu(w0 * xp[e] + w1 * xc[e] + w2 * xn[e]); }
    }
}
DI void load_rows16(const bf16_t* pp, bool hasp, bool hasn, u32x4* raw) {
    const u32x4 zero = {0u, 0u, 0u, 0u};
    raw[0] = hasp ? *(const u32x4*)(pp - 1536) : zero; raw[1] = hasp ? *(const u32x4*)(pp - 1536 + 8) : zero;
    raw[2] = *(const u32x4*)pp; raw[3] = *(const u32x4*)(pp + 8);
    raw[4] = hasn ? *(const u32x4*)(pp + 1536) : zero; raw[5] = hasn ? *(const u32x4*)(pp + 1536 + 8) : zero;
}

DI void phase_gdn_pre(const Params& p, int l, unsigned char* lds) {
    bf16_t* qL = (bf16_t*)lds;
    bf16_t* kL = qL + 64 * 136;
    bf16_t* kT = kL + 64 * 136;
    bf16_t* vT = kT + 128 * 72;
    float*  LF = (float*)(vT + 128 * 72);
    float*  LB = LF + 4096;
    bf16_t* TU = (bf16_t*)(LB + 4096);
    bf16_t* TW = TU + 2 * 64 * 72;
    float*  gv = (float*)(TW + 2 * 64 * 72);
    const bf16_t* PQ = (const bf16_t*)(p.ws + WS_PQ);
    const float* AB = (const float*)(p.ws + WS_AB);
    const float* cwq = p.conv_qkv + (size_t)l * 3 * 1536;
#define GDN_LOAD_UNIT(unx, tidx) do { const int cid_ = (unx) >> 2, h_ = (unx) & 3, c_ = (tidx) >> 3, cgp_ = (tidx) & 7, row_ = cid_ * 64 + c_; \
        const int pos_ = (cid_ < 32) ? ((cid_ & 3) * 64 + c_) : (((cid_ - 32) & 63) * 64 + c_); const int slen_ = (cid_ < 32) ? CTXL : SEQL; \
        const bool hasp_ = pos_ > 0, hasn_ = pos_ < slen_ - 1; const bf16_t* prow_ = PQ + (size_t)row_ * 1536 + h_ * 128 + cgp_ * 16; \
        load_rows16(prow_, hasp_, hasn_, rawq); load_rows16(prow_ + 512, hasp_, hasn_, rawk); load_rows16(prow_ + 1024, hasp_, hasn_, rawv); } while (0)
    for (int uo = opaque_bid(); uo < NUNITS; uo += gridDim.x) {
        int un;
        if (uo < 2048) { const int t = 31 - (uo >> 6), w = uo & 63, n = (w >> 5) ? 63 - t : t; un = (32 + ((w >> 2) & 7) * 64 + n) * 4 + (w & 3); }
        else un = uo - 2048;
        const int tid = opaque_tid();
        const int lane = tid & 63, wave = __builtin_amdgcn_readfirstlane(tid >> 6), r = lane & 31, hh = lane >> 5;
        const int cid = un >> 2, h = un & 3;
        unsigned char* GU = p.ws + WS_G + (size_t)un * UNIT_BYTES;
        u32x4 rawq[6], rawk[6], rawv[6];
        GDN_LOAD_UNIT(un, tid);
        float ab0 = 0.f, ab1 = 0.f, ab2 = 0.f, ab3 = 0.f;
        if (wave == 0) { const float* ab = AB + (size_t)(cid * 64 + lane) * 16; ab0 = ab[h]; ab1 = ab[4 + h]; ab2 = ab[8 + h]; ab3 = ab[12 + h]; }
        if (STEPON(0)) {
            const int c = tid >> 3, cgp = tid & 7;
            const float* cw = cwq + h * 128 + cgp * 16;
            float t[16];
            conv_silu16(rawq, cw, t);
            { float ss = 0.f;
#pragma unroll
              for (int e = 0; e < 16; ++e) ss += t[e] * t[e];
              ss += __shfl_xor(ss, 1); ss += __shfl_xor(ss, 2); ss += __shfl_xor(ss, 4);
              const float sc = rsqrtf(ss + EPSV) * 0.08838834764831845f;
#pragma unroll
              for (int e = 0; e < 16; ++e) t[e] *= sc; }
            { const u32x4 w0 = packw8(t), w1 = packw8(t + 8);
              *(u32x4*)(qL + c * 136 + cgp * 16) = w0; *(u32x4*)(qL + c * 136 + cgp * 16 + 8) = w1;
              const int frag = ((c >> 5) * 4 + (cgp >> 1)) * 2 + (cgp & 1);
              u32x4 f0, f1; f0.x = w0.x; f0.y = w0.y; f0.z = w1.x; f0.w = w1.y; f1.x = w0.z; f1.y = w0.w; f1.z = w1.z; f1.w = w1.w;
              u32x4* gq = (u32x4*)(GU + OFF_Q + frag * 1024);
              gq[c & 31] = f0; gq[32 + (c & 31)] = f1; }
            conv_silu16(rawk, cw + 512, t);
            { float ss = 0.f;
#pragma unroll
              for (int e = 0; e < 16; ++e) ss += t[e] * t[e];
              ss += __shfl_xor(ss, 1); ss += __shfl_xor(ss, 2); ss += __shfl_xor(ss, 4);
              const float sc = rsqrtf(ss + EPSV);
#pragma unroll
              for (int e = 0; e < 16; ++e) t[e] *= sc; }
            { *(u32x4*)(kL + c * 136 + cgp * 16) = packw8(t); *(u32x4*)(kL + c * 136 + cgp * 16 + 8) = packw8(t + 8);
#pragma unroll
              for (int e = 0; e < 16; ++e) kT[(cgp * 16 + e) * 72 + (c ^ (8 * cgp))] = bf1(t[e]); }
            conv_silu16(rawv, cw + 1024, t);
#pragma unroll
            for (int e = 0; e < 16; ++e) vT[(cgp * 16 + e) * 72 + (c ^ (8 * cgp))] = bf1(t[e]);
        }
        if (STEPON(1) && wave == 0) {
            const float bf_ = sigmf(ab0), bb_ = sigmf(ab1);
            float gf_ = -expf(p.a_log[l * 8 + h]) * softplusf(ab2 + p.dt_bias[l * 8 + h]);
            float gb_ = -expf(p.a_log[l * 8 + 4 + h]) * softplusf(ab3 + p.dt_bias[l * 8 + 4 + h]);
#pragma unroll
            for (int o = 1; o < 64; o <<= 1) { const float t1 = __shfl_up(gf_, o); if (lane >= o) gf_ += t1; const float t2 = __shfl_down(gb_, o); if (lane + o < 64) gb_ += t2; }
            gv[lane] = gf_; gv[64 + lane] = gb_; gv[128 + lane] = bf_; gv[192 + lane] = bb_;
            const float gfl = __shfl(gf_, 63), gbl = __shfl(gb_, 0);
            float* sc = (float*)(GU + OFF_SC);
            sc[lane] = expf(gf_); sc[64 + lane] = expf(gfl - gf_); if (lane < 4) sc[128 + lane] = expf(gfl);
            sc[132 + lane] = expf(gb_); sc[196 + lane] = expf(gbl - gb_); if (lane < 4) sc[260 + lane] = expf(gbl);
        }
        LBAR();
        if (STEPON(2)) {
            const int kind = wave >> 2, ti = (wave >> 1) & 1, tj = wave & 1;
            const bf16_t* Ab = kL + (32 * ti + r) * 136 + 8 * hh;
            const bf16_t* Bb = (kind ? qL : kL) + (32 * tj + r) * 136 + 8 * hh;
            f32x16 z;
#pragma unroll
            for (int i = 0; i < 16; ++i) z[i] = 0.f;
#pragma unroll
            for (int ks = 0; ks < 8; ++ks) z = MFMA32(*(const bf16x8*)(Ab + 16 * ks), *(const bf16x8*)(Bb + 16 * ks), z);
            const int cj = 32 * tj + r;
            const float gFj = gv[cj], gBj = gv[64 + cj];
            if (kind == 0) {
#pragma unroll
                for (int i = 0; i < 16; ++i) { const int ci = 32 * ti + crow(i, hh);
                    const float gFi = gv[ci], gBi = gv[64 + ci];
                    LF[ci * 64 + cj] = ci > cj ? z[i] * __expf(fminf(gFi - gFj, 0.f)) * gv[128 + ci] : 0.f;
                    LB[(63 - ci) * 64 + (63 - cj)] = ci < cj ? z[i] * __expf(fminf(gBi - gBj, 0.f)) * gv[192 + ci] : 0.f; }
            } else {
                f32x16 vf, vb;
#pragma unroll
                for (int i = 0; i < 16; ++i) { const int cp = 32 * ti + crow(i, hh);
                    vf[i] = cj >= cp ? z[i] * __expf(fminf(gFj - gv[cp], 0.f)) : 0.f;
                    vb[i] = cj <= cp ? z[i] * __expf(fminf(gBj - gv[64 + cp], 0.f)) : 0.f; }
#pragma unroll
                for (int s = 0; s < 2; ++s) {
                    *(bf16x8*)(GU + OFF_D0 + OFF_QK + ((tj * 2 + ti) * 2 + s) * 1024 + lane * 16) = pack16s(vf, s);
                    *(bf16x8*)(GU + OFF_D0 + DIR_BYTES + OFF_QK + ((tj * 2 + ti) * 2 + s) * 1024 + lane * 16) = pack16s(vb, s); }
            }
        }
        LBAR();
        if (STEPON(3) && wave < 2) {
            unsigned la = (unsigned)(size_t)(PG8_LAS float*)LF + (wave ? 16384u : 0u); asm volatile("" : "+v"(la));
            const PG8_LAS float* L = (const PG8_LAS float*)la;
            f32x2 T2[32];
#define TT(m) (T2[(m) >> 1][(m) & 1])
            f32x4 lcur[16], lnxt[16];
#pragma unroll
            for (int m4 = 0; m4 < 16; ++m4) { lcur[m4] = (f32x4){0.f, 0.f, 0.f, 0.f}; lnxt[m4] = lcur[m4]; }
#pragma unroll
            for (int k = 0; k < 32; ++k) T2[k] = (f32x2){0.f, 0.f};
            lcur[0] = *(const PG8_LAS f32x4*)(L + 64);
            T2[0][0] = (lane == 0) ? 1.f : 0.f;
#pragma unroll
            for (int i = 1; i < 64; ++i) {
                if (i + 1 < 64) {
#pragma unroll
                    for (int m4 = 0; m4 < (i + 4) / 4; ++m4) lnxt[m4] = *(const PG8_LAS f32x4*)(L + (i + 1) * 64 + 4 * m4);
                }
                __builtin_amdgcn_sched_barrier(0);
                f32x2 a0 = {(lane == i) ? 1.f : 0.f, 0.f}, a1 = {0.f, 0.f};
#pragma unroll
                for (int k = 0; k < i / 2; ++k) {
                    const f32x2 l2 = (k & 1) ? (f32x2){lcur[k >> 1][2], lcur[k >> 1][3]} : (f32x2){lcur[k >> 1][0], lcur[k >> 1][1]};
                    if (k & 1) a1 -= l2 * T2[k]; else a0 -= l2 * T2[k]; }
                float rsum = (a0[0] + a0[1]) + (a1[0] + a1[1]);
                if (i & 1) rsum -= lcur[(i - 1) >> 2][(i - 1) & 3] * TT(i - 1);
                TT(i) = rsum;
                __builtin_amdgcn_sched_barrier(0);
#pragma unroll
                for (int m4 = 0; m4 < (i + 4) / 4; ++m4) lcur[m4] = lnxt[m4];
            }
            const int cj = wave ? 63 - lane : lane;
            const float bj = gv[(wave ? 192 : 128) + cj], ej = expf(gv[(wave ? 64 : 0) + cj]);
            unsigned tu = (unsigned)(size_t)(PG8_LAS bf16_t*)TU + (wave ? (4608u + (unsigned)cj) * 2u : (unsigned)cj * 2u); asm volatile("" : "+v"(tu));
            PG8_LAS bf16_t* TUp = (PG8_LAS bf16_t*)tu; PG8_LAS bf16_t* TWp = TUp + 2 * 64 * 72;
            if (wave == 0) {
#pragma unroll
                for (int i = 0; i < 64; ++i) { TUp[i * 72] = bf1(TT(i) * bj); TWp[i * 72] = bf1(TT(i) * bj * ej); }
            } else {
#pragma unroll
                for (int i = 0; i < 64; ++i) { TUp[(63 - i) * 72] = bf1(TT(i) * bj); TWp[(63 - i) * 72] = bf1(TT(i) * bj * ej); }
            }
        }
        LBAR();
#pragma unroll
        for (int q4 = 0; q4 < (STEPON(4) ? 4 : 0); ++q4) {
            const int d = q4 >> 1, kind = q4 & 1;
            f32x16 z;
#pragma unroll
            for (int i = 0; i < 16; ++i) z[i] = 0.f;
            if (kind == 0) {
                const int tM = wave >> 1, tN = wave & 1;
                const int swz = 8 * (((32 * tM + r) >> 4) & 7);
                const bf16_t* Ab = kT + (32 * tM + r) * 72;
                const bf16_t* Bb = TW + d * 4608 + (32 * tN + r) * 72 + 8 * hh;
#pragma unroll
                for (int ks = 0; ks < 4; ++ks) z = MFMA32(*(const bf16x8*)(Ab + ((8 * hh + 16 * ks) ^ swz)), *(const bf16x8*)(Bb + 16 * ks), z);
#pragma unroll
                for (int s = 0; s < 2; ++s) *(bf16x8*)(GU + OFF_D0 + d * DIR_BYTES + OFF_W + ((tN * 4 + tM) * 2 + s) * 1024 + lane * 16) = pack16s(z, s);
            } else {
                const int tM = wave >> 2, tN = wave & 3;
                const bf16_t* Ab = TU + d * 4608 + (32 * tM + r) * 72 + 8 * hh;
                const int swz = 8 * (((32 * tN + r) >> 4) & 7);
                const bf16_t* Bb = vT + (32 * tN + r) * 72;
#pragma unroll
                for (int ks = 0; ks < 4; ++ks) z = MFMA32(*(const bf16x8*)(Ab + 16 * ks), *(const bf16x8*)(Bb + ((8 * hh + 16 * ks) ^ swz)), z);
                bf16x8* gu = (bf16x8*)(GU + OFF_D0 + d * DIR_BYTES + OFF_U + ((tN * 2 + tM) * 64 + lane) * 32);
                gu[0] = pack16s(z, 0); gu[1] = pack16s(z, 1);
            }
        }
#pragma unroll
        for (int f2 = 0; f2 < 2; ++f2) { const int fl = tid + 512 * f2, f = fl >> 6, ln = fl & 63, r2 = ln & 31, h2 = ln >> 5, mt = f >> 2, kt = (f >> 1) & 1, s = f & 1;
            const int swz = 8 * (((32 * mt + r2) >> 4) & 7), c0 = 32 * kt + 16 * s + 4 * h2;
            const bf16_t* src = kT + (32 * mt + r2) * 72;
            const u32x2 lo = *(const u32x2*)(src + (c0 ^ swz)), hi = *(const u32x2*)(src + ((c0 + 8) ^ swz));
            u32x4 o; o.x = lo.x; o.y = lo.y; o.z = hi.x; o.w = hi.y;
            *(u32x4*)(GU + OFF_KT + f * 1024 + ln * 16) = o; }
        LBAR();
    }
}

DI int scan_cid(int b, int d, int st) { return st < 4 ? (b * 4 + (d ? 3 - st : st)) : (32 + b * 64 + (d ? 67 - st : st - 4)); }
DI void phase_scan(const Params& p, int l, unsigned char* lds) {
    const int bid = opaque_bid();
    if (bid >= 64) return;
    const int b = bid >> 3, h = (bid >> 1) & 3, d = bid & 1;
    const unsigned char* G = p.ws + WS_G;
    bf16_t* OD = (bf16_t*)(p.ws + (d ? WS_OB : WS_OF));
    const int tid0 = opaque_tid();
    if (__builtin_amdgcn_readfirstlane(tid0 >> 6) >= 4) {
        const int lt = tid0 - 256;
#define SCAN_SRC(U, o) ((o) < 32768 ? (U) + (o) : (U) + OFF_D0 + d * DIR_BYTES + ((o) - 32768))
#define SCAN_LD(set, sets, step) do { const unsigned char* U_ = G + (size_t)(scan_cid(b, d, (step)) * 4 + h) * UNIT_BYTES; \
        _Pragma("unroll") for (int i_ = 0; i_ < 18; ++i_) { const int o_ = (lt + 256 * i_) * 16; set[i_] = *(const u32x4*)SCAN_SRC(U_, o_); } \
        if (lt < 33) sets = *(const u32x4*)(U_ + OFF_SC + d * SC_BYTES + lt * 16); } while (0)
#define SCAN_ST(set, sets, step) do { unsigned char* dst_ = lds + ((step) & 1) * SCAN_BUF; \
        _Pragma("unroll") for (int i_ = 0; i_ < 18; ++i_) *(u32x4*)(dst_ + (lt + 256 * i_) * 16) = set[i_]; \
        if (lt < 33) *(u32x4*)(dst_ + 73728 + lt * 16) = sets; } while (0)
        u32x4 sA[18], sB[18]; u32x4 sAs = {0u, 0u, 0u, 0u}, sBs = sAs;
        SCAN_LD(sA, sAs, 0); SCAN_ST(sA, sAs, 0);
        SCAN_LD(sA, sAs, 1); SCAN_LD(sB, sBs, 2);
        LBAR();
        unsigned* prog = (unsigned*)(p.ws + WS_BAR + 14336) + bid * 8;
        for (int st = 0; st < 68; st += 2) {
            SCAN_ST(sA, sAs, st + 1);
            if (st + 3 < 68) SCAN_LD(sA, sAs, st + 3);
            LBAR();
            if (lt == 0) __hip_atomic_store(prog, (unsigned)(l * 1000 + st + 1), __ATOMIC_RELAXED, __HIP_MEMORY_SCOPE_AGENT);
            if (st + 2 < 68) SCAN_ST(sB, sBs, st + 2);
            if (st + 4 < 68) SCAN_LD(sB, sBs, st + 4);
            LBAR();
            if (lt == 0) __hip_atomic_store(prog, (unsigned)(l * 1000 + st + 2), __ATOMIC_RELAXED, __HIP_MEMORY_SCOPE_AGENT);
        }
        return;
    }
    LBAR();
    __builtin_amdgcn_s_setprio(2);
    f32x16 S[4];
#pragma unroll
    for (int k = 0; k < 4; ++k)
#pragma unroll
        for (int i = 0; i < 16; ++i) S[k][i] = 0.f;
    for (int st = 0; st < 68; ++st) {
        const int cur = st & 1;
        const int cid = scan_cid(b, d, st);
        int tidv = threadIdx.x; asm volatile("" : "+v"(tidv));
        const int lane = tidv & 63, wave = __builtin_amdgcn_readfirstlane(tidv >> 6), r = lane & 31, hh = lane >> 5;
        {
            const unsigned char* B0 = lds + cur * SCAN_BUF;
            const bf16x8* Aq = (const bf16x8*)(B0) + lane;
            const bf16x8* AkT = (const bf16x8*)(B0 + 16384) + lane;
            const bf16x8* Aw = (const bf16x8*)(B0 + 32768) + lane;
            const bf16x8* Aqk = (const bf16x8*)(B0 + 49152) + lane;
            const float* scl = (const float*)(B0 + 73728);
            const unsigned char* UU = B0 + 32768 + OFF_U;
            f32x16 ws[2], qs[2];
#pragma unroll
            for (int mt = 0; mt < 2; ++mt)
#pragma unroll
                for (int i = 0; i < 16; ++i) { ws[mt][i] = 0.f; qs[mt][i] = 0.f; }
#define SCAN_SB() __builtin_amdgcn_sched_barrier(0)
#define SCAN_LOADB(dst, kt) do { _Pragma("unroll") for (int s_ = 0; s_ < 2; ++s_) { const int f_ = (kt) * 2 + s_; dst[4 * s_ + 0] = Aw[f_ * 64]; dst[4 * s_ + 1] = Aw[(8 + f_) * 64]; dst[4 * s_ + 2] = Aq[f_ * 64]; dst[4 * s_ + 3] = Aq[(8 + f_) * 64]; } } while (0)
#define SCAN_MMAB(src, kt) do { _Pragma("unroll") for (int s_ = 0; s_ < 2; ++s_) { const bf16x8 sb_ = pack16s(S[kt], s_); ws[0] = MFMA32(src[4 * s_ + 0], sb_, ws[0]); ws[1] = MFMA32(src[4 * s_ + 1], sb_, ws[1]); qs[0] = MFMA32(src[4 * s_ + 2], sb_, qs[0]); qs[1] = MFMA32(src[4 * s_ + 3], sb_, qs[1]); } } while (0)
            bf16x8 fa[8], fb[8];
            SCAN_LOADB(fa, 0); SCAN_LOADB(fb, 1); SCAN_SB();
            SCAN_MMAB(fa, 0); SCAN_SB(); SCAN_LOADB(fa, 2); SCAN_SB();
            SCAN_MMAB(fb, 1); SCAN_SB(); SCAN_LOADB(fb, 3); SCAN_SB();
            SCAN_MMAB(fa, 2); SCAN_SB();
#pragma unroll
            for (int i = 0; i < 8; ++i) fa[i] = Aqk[i * 64];
            SCAN_SB();
            SCAN_MMAB(fb, 3); SCAN_SB();
            f32x16 vn[2];
#pragma unroll
            for (int mt = 0; mt < 2; ++mt) {
                const u32x4* up = (const u32x4*)(UU + ((wave * 2 + mt) * 64 + lane) * 32);
                const u32x4 u0 = up[0], u1 = up[1];
                f32x4 es[4];
#pragma unroll
                for (int g = 0; g < 4; ++g) es[g] = *(const f32x4*)(scl + 32 * mt + 8 * g + 4 * hh);
                float uf[16]; unpack8(u0, uf); unpack8(u1, uf + 8);
#pragma unroll
                for (int i = 0; i < 16; ++i) vn[mt][i] = uf[i] - ws[mt][i];
#pragma unroll
                for (int g = 0; g < 4; ++g)
#pragma unroll
                    for (int j = 0; j < 4; ++j) qs[mt][4 * g + j] *= es[g][j];
            }
            SCAN_SB();
#pragma unroll
            for (int i = 0; i < 8; ++i) fb[i] = AkT[i * 64];
            SCAN_SB();
            {
                bf16x8 vb[2][2];
#pragma unroll
                for (int kt = 0; kt < 2; ++kt)
#pragma unroll
                    for (int s = 0; s < 2; ++s) vb[kt][s] = pack16s(vn[kt], s);
#pragma unroll
                for (int kt = 0; kt < 2; ++kt)
#pragma unroll
                    for (int s = 0; s < 2; ++s) { qs[0] = MFMA32(fa[(0 * 2 + kt) * 2 + s], vb[kt][s], qs[0]); qs[1] = MFMA32(fa[(1 * 2 + kt) * 2 + s], vb[kt][s], qs[1]); }
            }
            SCAN_SB();
#pragma unroll
            for (int i = 0; i < 8; ++i) fa[i] = AkT[(8 + i) * 64];
            f32x4 et[2][4];
#pragma unroll
            for (int mt = 0; mt < 2; ++mt)
#pragma unroll
                for (int g = 0; g < 4; ++g) et[mt][g] = *(const f32x4*)(scl + 64 + 32 * mt + 8 * g + 4 * hh);
            const float decay = scl[128];
            SCAN_SB();
            {
                bf16x8 vt[2][2];
#pragma unroll
                for (int mt = 0; mt < 2; ++mt) {
#pragma unroll
                    for (int g = 0; g < 4; ++g)
#pragma unroll
                        for (int j = 0; j < 4; ++j) vn[mt][4 * g + j] *= et[mt][g][j];
                    vt[mt][0] = pack16s(vn[mt], 0); vt[mt][1] = pack16s(vn[mt], 1);
                }
#pragma unroll
                for (int mt = 0; mt < 4; ++mt) {
#pragma unroll
                    for (int i = 0; i < 16; ++i) S[mt][i] *= decay;
#pragma unroll
                    for (int kt = 0; kt < 2; ++kt)
#pragma unroll
                        for (int s = 0; s < 2; ++s) S[mt] = MFMA32((mt < 2 ? fb : fa)[((mt & 1) * 2 + kt) * 2 + s], vt[kt][s], S[mt]);
                }
            }
            if (l == 0 || cid >= 32) {
#pragma unroll
                for (int mt = 0; mt < 2; ++mt)
#pragma unroll
                    for (int i = 0; i < 16; ++i) OD[(size_t)(cid * 64 + 32 * mt + crow(i, hh)) * 512 + h * 128 + 32 * wave + r] = bf1(qs[mt][i]);
            }
        }
        LBAR();
    }
    __builtin_amdgcn_s_setprio(0);
}

DI void scan_helper(const Params& p, int l, int s) {
    const int b = s >> 3, h = (s >> 1) & 3, d = s & 1;
    const unsigned char* G = p.ws + WS_G;
    unsigned* prog = (unsigned*)(p.ws + WS_BAR + 14336) + s * 8;
    constexpr int LEAD = 5;
    unsigned acc = 0u;
    for (int st = 4; st < 68; ++st) {
        const int tid = opaque_tid();
        if (tid == 0) { const int want = l * 1000 + st - LEAD; while ((int)__hip_atomic_load(prog, __ATOMIC_RELAXED, __HIP_MEMORY_SCOPE_AGENT) < want) __builtin_amdgcn_s_sleep(8); }
        LBAR();
        const unsigned char* U = G + (size_t)(scan_cid(b, d, st) * 4 + h) * UNIT_BYTES;
        for (int ln = tid; ln < 581; ln += 512) {
            const int off = ln < 256 ? ln * 128 : (ln < 576 ? OFF_D0 + d * DIR_BYTES + (ln - 256) * 128 : OFF_SC + d * SC_BYTES + (ln - 576) * 128);
            acc += *(const unsigned*)(U + off);
        }
    }
    if (acc == 0x9e3779b9u) prog[1] = acc;
}

template <int MODE> DI void phase_mix(const Params& p, int l, unsigned char* lds, int b0, int nb) {
    const bf16_t* PA = (const bf16_t*)(p.ws + WS_PA);
    const bf16_t* PZ = (const bf16_t*)(p.ws + WS_PZ);
    const bf16_t* OF = (const bf16_t*)(p.ws + WS_OF);
    const bf16_t* OB = (const bf16_t*)(p.ws + WS_OB);
    bf16_t* YM = (bf16_t*)(p.ws + WS_YMIX);
    bf16_t* YAC = (bf16_t*)(p.ws + WS_YAC);
    const int cu_lo = l ? 16 : 0, cid_lo = l ? 32 : 0;
    const int nC = MODE == 0 ? 272 - cu_lo : 0, nAB = 544 - cid_lo;
    for (int un = opaque_bid() - b0; un < nC + nAB; un += nb) {
        const int tid = opaque_tid(), lane = tid & 63, wave = __builtin_amdgcn_readfirstlane(tid >> 6), r = lane & 31, hh = lane >> 5;
        if (un < nC) {
            const int R0 = (cu_lo + un) * 128;
            bf16_t* vT = (bf16_t*)lds;
            {
                const int rr = tid >> 2, g = tid & 3, row = R0 + rr;
                const bf16_t* src = PZ + (size_t)row * 1024 + 768 + g * 64;
                float v[64];
#pragma unroll
                for (int i = 0; i < 8; ++i) unpack8(*(const u32x4*)(src + 8 * i), v + 8 * i);
                float sum = 0.f;
#pragma unroll
                for (int e = 0; e < 64; ++e) { v[e] = fgelu(v[e]); sum += v[e]; }
                sum += __shfl_xor(sum, 1); sum += __shfl_xor(sum, 2);
                const float mu = sum * (1.f / 256.f);
                float var = 0.f;
#pragma unroll
                for (int e = 0; e < 64; ++e) { const float dlt = v[e] - mu; var += dlt * dlt; }
                var += __shfl_xor(var, 1); var += __shfl_xor(var, 2);
                const float rstd = rsqrtf(var * (1.f / 256.f) + EPSV);
                const float* lg = p.ln_c_g + l * 256 + g * 64; const float* lb = p.ln_c_b + l * 256 + g * 64;
#pragma unroll
                for (int e = 0; e < 64; ++e) vT[(g * 64 + e) * 136 + rr] = bf1((v[e] - mu) * rstd * lg[e] + lb[e]);
            }
            LBAR();
            {
                const int g2 = wave >> 1, ph = wave & 1;
                f32x16 acc[2][2];
#pragma unroll
                for (int a = 0; a < 2; ++a)
#pragma unroll
                    for (int bq = 0; bq < 2; ++bq)
#pragma unroll
                        for (int i = 0; i < 16; ++i) acc[a][bq][i] = 0.f;
                const float* Wg = p.w_s + (size_t)(l * 4 + g2) * 128 * 128;
#pragma unroll 2
                for (int ks = 0; ks < 8; ++ks) {
                    bf16x8 a[2], bb[2];
#pragma unroll
                    for (int mt = 0; mt < 2; ++mt) { const float* wp = Wg + (size_t)(64 * ph + 32 * mt + r) * 128 + 16 * ks + 8 * hh;
                        const f32x4 w0 = *(const f32x4*)wp, w1 = *(const f32x4*)(wp + 4);
                        u32x4 w; w.x = pkbf(w0.x, w0.y); w.y = pkbf(w0.z, w0.w); w.z = pkbf(w1.x, w1.y); w.w = pkbf(w1.z, w1.w); a[mt] = __builtin_bit_cast(bf16x8, w); }
#pragma unroll
                    for (int nt = 0; nt < 2; ++nt) bb[nt] = *(const bf16x8*)(vT + (g2 * 64 + 32 * nt + r) * 136 + 16 * ks + 8 * hh);
#pragma unroll
                    for (int mt = 0; mt < 2; ++mt)
#pragma unroll
                        for (int nt = 0; nt < 2; ++nt) acc[mt][nt] = MFMA32(a[mt], bb[nt], acc[mt][nt]);
                }
                const float* bs = p.b_s + (size_t)(l * 4 + g2) * 128;
                bf16_t cuw[2][2][16];
#pragma unroll
                for (int mt = 0; mt < 2; ++mt)
#pragma unroll
                    for (int nt = 0; nt < 2; ++nt)
#pragma unroll
                        for (int i = 0; i < 16; ++i) { const int prow = 64 * ph + 32 * mt + crow(i, hh), row = R0 + prow, ch = g2 * 64 + 32 * nt + r;
                            cuw[mt][nt][i] = PZ[(size_t)row * 1024 + 512 + ch]; }
#pragma unroll
                for (int mt = 0; mt < 2; ++mt)
#pragma unroll
                    for (int nt = 0; nt < 2; ++nt)
#pragma unroll
                        for (int i = 0; i < 16; ++i) { const int prow = 64 * ph + 32 * mt + crow(i, hh), row = R0 + prow, ch = g2 * 64 + 32 * nt + r;
                            YAC[(size_t)row * 512 + 256 + ch] = bf1(fgelu(bf2f(cuw[mt][nt][i])) * (acc[mt][nt][i] + bs[prow])); }
            }
            LBAR();
        } else {
            const int cid = cid_lo + (un - nC);
            const int c = tid >> 3, sub = tid & 7, row = cid * 64 + c;
            const bool isctx = cid < 32;
            const int pos = isctx ? ((cid & 3) * 64 + c) : (((cid - 32) & 63) * 64 + c);
            {
                const bool vert = (!isctx) && (sub >= 4);
                const int dstep = vert ? 64 : 1;
                bool hasp, hasn;
                if (isctx) { hasp = pos > 0; hasn = pos < CTXL - 1; }
                else if (!vert) { const int col = pos & 63; hasp = col > 0; hasn = col < 63; }
                else { hasp = pos >= 64; hasn = pos < SEQL - 64; }
                const u32x4 zero = {0u, 0u, 0u, 0u};
                if (MODE == 0) {
                const bf16_t* pa = PA + (size_t)row * 768 + sub * 32;
#pragma unroll 1
                for (int hb2 = 0; hb2 < 4; hb2 += 2) {
                    u32x4 rab[2], rcc[2], rch[2], rpc[2], rph[2], rnc[2], rnh[2];
#pragma unroll
                    for (int q = 0; q < 2; ++q) { const int hb = hb2 + q;
                        rab[q] = *(const u32x4*)(pa + hb * 8); rcc[q] = *(const u32x4*)(pa + 256 + hb * 8); rch[q] = *(const u32x4*)(pa + 512 + hb * 8);
                        rpc[q] = hasp ? *(const u32x4*)(pa - (size_t)dstep * 768 + 256 + hb * 8) : zero; rph[q] = hasp ? *(const u32x4*)(pa - (size_t)dstep * 768 + 512 + hb * 8) : zero;
                        rnc[q] = hasn ? *(const u32x4*)(pa + (size_t)dstep * 768 + 256 + hb * 8) : zero; rnh[q] = hasn ? *(const u32x4*)(pa + (size_t)dstep * 768 + 512 + hb * 8) : zero; }
#pragma unroll
                    for (int q = 0; q < 2; ++q) { const int hb = hb2 + q;
                        const float* cw = p.conv_a + (size_t)l * 768 + sub * 32 + hb * 8;
                        float ab_[8], cc[8], ch_[8], pc[8], ph_[8], nc[8], nh[8];
                        unpack8(rab[q], ab_); unpack8(rcc[q], cc); unpack8(rch[q], ch_); unpack8(rpc[q], pc); unpack8(rph[q], ph_); unpack8(rnc[q], nc); unpack8(rnh[q], nh);
                        float o[8];
#pragma unroll
                        for (int e = 0; e < 8; ++e) o[e] = ab_[e] * (cw[e] * (pc[e] * ph_[e]) + cw[256 + e] * (cc[e] * ch_[e]) + cw[512 + e] * (nc[e] * nh[e]));
                        *(u32x4*)(YAC + (size_t)row * 512 + sub * 32 + hb * 8) = packw8(o); }
                }
                } else {
                const int head = sub >> 1, hf = sub & 1;
                const size_t ob = (size_t)row * 512 + head * 128 + hf * 64;
                const bf16_t* zp = PZ + (size_t)row * 1024 + head * 128 + hf * 64;
                u32x4 rof[8], rob[8], rz[8], rcp[8];
#pragma unroll
                for (int i = 0; i < 8; ++i) { rof[i] = *(const u32x4*)(OF + ob + 8 * i); rob[i] = *(const u32x4*)(OB + ob + 8 * i); rz[i] = *(const u32x4*)(zp + 8 * i);
                    rcp[i] = *(const u32x4*)(YAC + (size_t)row * 512 + sub * 64 + 8 * i); }
                { bf16_t* cd = YM + (size_t)row * 1024 + (sub < 4 ? sub * 64 : 768 + (sub - 4) * 64);
#pragma unroll
                  for (int i = 0; i < 8; ++i) *(u32x4*)(cd + 8 * i) = rcp[i]; }
                float ss = 0.f;
#pragma unroll
                for (int i = 0; i < 8; ++i) { float a[8], bq[8]; unpack8(rof[i], a); unpack8(rob[i], bq);
#pragma unroll
                    for (int e = 0; e < 8; ++e) { const float o = a[e] + bq[e]; ss += o * o; } }
                ss += __shfl_xor(ss, 1);
                const float rstd = rsqrtf(ss * (1.f / 128.f) + EPSV);
                const float* gw = p.g_onorm + l * 128 + hf * 64;
                bf16_t* yo = YM + (size_t)row * 1024 + 256 + head * 128 + hf * 64;
#pragma unroll
                for (int i = 0; i < 8; ++i) { float a[8], bq[8], zz[8], o[8]; unpack8(rof[i], a); unpack8(rob[i], bq); unpack8(rz[i], zz);
#pragma unroll
                    for (int e = 0; e < 8; ++e) o[e] = (a[e] + bq[e]) * rstd * gw[8 * i + e] * fsilu(zz[e]);
                    *(u32x4*)(yo + 8 * i) = packw8(o); }
                }
            }
        }
    }
}


#define LAS __attribute__((address_space(3)))
#define XB_TMO      128
#define XB_XCNT(j)  (256  + 64 * (j))
#define XB_XSUB(j)  (1280 + 64 * (j))
#define XB_XGEN(j)  (2304 + 64 * (j))
#define XB_TOP      3328
#define XB_TOPGEN   3392
#define XCD_BAR_WORDS 3456
#define XB_SPIN_CAP (1u << 18)

__device__ __forceinline__ unsigned xb_ld(unsigned* p)              { return __hip_atomic_load(p, __ATOMIC_RELAXED, __HIP_MEMORY_SCOPE_AGENT); }
__device__ __forceinline__ unsigned xb_add(unsigned* p, unsigned v) { return __hip_atomic_fetch_add(p, v, __ATOMIC_RELAXED, __HIP_MEMORY_SCOPE_AGENT); }
__device__ __forceinline__ unsigned xb_xcc_id() { return (unsigned)__builtin_amdgcn_s_getreg((3 << 11) | 20) & 0xFu; }
#define XB_SPIN(cond, bar) do { unsigned _sp = 0; while (cond) { __builtin_amdgcn_s_sleep(1); \
    if ((++_sp & 255u) == 0u) { if (xb_ld(&(bar)[XB_TMO])) break; if (_sp > XB_SPIN_CAP) { atomicAdd(&(bar)[XB_TMO], 1u); break; } } } } while (0)

struct XcdBarrier {
    unsigned* bar; unsigned x;
    volatile LAS unsigned* st;
};

__device__ __forceinline__ XcdBarrier xcd_barrier_post(unsigned* bar, volatile LAS unsigned* st) {
    XcdBarrier b; b.bar = bar; b.x = xb_xcc_id(); b.st = st;
    if (threadIdx.x == 0) (void)xb_add(&bar[XB_XCNT(b.x)], 1u);
    return b;
}
__device__ __forceinline__ void xcd_barrier_complete(unsigned* bar, unsigned x, unsigned& nloc, unsigned& nx) {
    const unsigned G = gridDim.x * gridDim.y * gridDim.z;
    unsigned sum, cnt, mine, sp = 0u;
    for (;;) {
        sum = 0u; cnt = 0u; mine = 0u;
#pragma unroll
        for (unsigned j = 0; j < 16; ++j) { const unsigned c = xb_ld(&bar[XB_XCNT(j)]); sum += c; cnt += (c > 0u) ? 1u : 0u; mine = (j == x) ? c : mine; }
        if (sum == G) break;
        __builtin_amdgcn_s_sleep(1);
        if ((++sp & 255u) == 0u) { if (xb_ld(&bar[XB_TMO])) break; if (sp > XB_SPIN_CAP) { atomicAdd(&bar[XB_TMO], 1u); break; } }
    }
    nloc = mine > 0u ? mine : 1u; nx = cnt > 0u ? cnt : 1u;
}

__device__ __forceinline__ void xcd_barrier(const XcdBarrier& b) {
    asm volatile("s_waitcnt vmcnt(0)" ::: "memory");
    __syncthreads();
    if (threadIdx.x == 0) {
        unsigned* bar = b.bar;
        __builtin_amdgcn_s_waitcnt(0);
        unsigned nloc = b.st[0], nx = b.st[1];
        if (nloc == 0u) { xcd_barrier_complete(bar, b.x, nloc, nx); b.st[0] = nloc; b.st[1] = nx; }
        const unsigned old = xb_add(&bar[XB_XSUB(b.x)], 1u);
        const unsigned gen = old / nloc;
        if (old + 1u == (gen + 1u) * nloc) {
            __builtin_amdgcn_fence(__ATOMIC_RELEASE, "agent");
            asm volatile("s_waitcnt vmcnt(0)" ::: "memory");
            const unsigned og = xb_add(&bar[XB_TOP], 1u);
            const unsigned tg = og / nx;
            if (og + 1u == (tg + 1u) * nx) xb_add(&bar[XB_TOPGEN], 1u);
            else XB_SPIN(xb_ld(&bar[XB_TOPGEN]) == tg, bar);
            __builtin_amdgcn_fence(__ATOMIC_ACQUIRE, "agent");
            xb_add(&bar[XB_XGEN(b.x)], 1u);
            asm volatile("s_waitcnt vmcnt(0)" ::: "memory");
        } else {
            XB_SPIN(xb_ld(&bar[XB_XGEN(b.x)]) == gen, bar);
            __builtin_amdgcn_fence(__ATOMIC_ACQUIRE, "agent");
            asm volatile("s_waitcnt vmcnt(0)" ::: "memory");
        }
    }
    __syncthreads();
}

constexpr int NPHASES = 20;
#ifndef PH_MASK
#define PH_MASK 0xFFFF
#endif
#define PHON(i) (((PH_MASK) >> (i)) & 1)
template <int PH> DI void run_phase(const Params& p, unsigned char* smem, PG8_LAS unsigned char* lds3, const int G) {
    const int bx = opaque_bid();
    float* MOD = (float*)(p.ws + WS_MOD); float* XC = (float*)(p.ws + WS_XC); bf16_t* H = (bf16_t*)(p.ws + WS_H);
    if constexpr (PH == 0) { phase_mod(p, smem); phase_convert<0>(p, 0, smem); }
    else if constexpr (PH == 1) { rowpass<0, true>(0, p.x, p.ctx, nullptr, nullptr, nullptr, nullptr, 0, nullptr, nullptr, p.g_pre_mix, MOD, 0, H); }
    else {
        constexpr int l = (PH - 2) / 9, k = (PH - 2) % 9;
        constexpr int rlo = l ? RC : 0;
        const float* xin_x = l ? p.out : p.x; const float* xin_c = l ? XC : p.ctx;
        const float* modl = MOD + (size_t)l * 9 * 6144;
        if constexpr (k == 0) {
            pg8::Gemm g{(const bf16_t*)H, (const bf16_t*)(p.ws + WS_WIN), RT, NIN, 1024, 1024}; pg8::StaticOrder S; S.init(RT, NIN, G, bx);
            EpiInProj E{(bf16_t*)(p.ws + WS_PA), (bf16_t*)(p.ws + WS_PQ), (bf16_t*)(p.ws + WS_PZ), (float*)(p.ws + WS_AB)};
            pg8::gemm_phase<EpiInProj, pg8::StaticOrder, false, true>(lds3, g, S, E);
        } else if constexpr (k == 1) { phase_gdn_pre(p, l, smem); }
        else if constexpr (k == 2) { if (bx < 64) phase_scan(p, l, smem); else if (G >= 256 && bx < 128) scan_helper(p, l, bx - 64); else if (G >= 256 && bx < 160) phase_convert<1>(p, l, smem, 128, 32); else { if (G < 256 && bx == 64) phase_convert<1>(p, l, smem, 64, 1); const int b0 = G >= 256 ? 160 : 64; phase_mix<0>(p, l, smem, b0, G - b0); } }
        else if constexpr (k == 3) { phase_mix<1>(p, l, smem, 0, G); }
        else if constexpr (k == 4) {
            {
                pg8::Gemm g{(const bf16_t*)(p.ws + WS_YMIX) + (size_t)RC * 1024, (const bf16_t*)(p.ws + WS_WO), RX, 1024, 1024, 1024}; pg8::StaticOrder S; S.init(RX, 1024, G, bx);
                EpiBf16Out E{(bf16_t*)(p.ws + WS_YO) + (size_t)RC * 1024, 1024};
                pg8::gemm_phase<EpiBf16Out, pg8::StaticOrder, false, true>(lds3, g, S, E); }
            if constexpr (l == 0) {
#pragma unroll 1
                for (int hk = 0; hk < 2; ++hk) {
                    pg8::Gemm g{(const bf16_t*)(p.ws + WS_YMIX) + hk * 512, (const bf16_t*)(p.ws + WS_WO) + hk * 512, RC, 1024, 512, 1024}; pg8::StaticOrder S; S.init(RC, 1024, G, (bx + G - 32 * hk) % G);
                    EpiBf16Out E{hk ? (bf16_t*)(p.ws + WS_CTXB) : (bf16_t*)(p.ws + WS_YO), 1024};
                    pg8::gemm_phase<EpiBf16Out, pg8::StaticOrder, false, true>(lds3, g, S, E); }
            }
        } else if constexpr (k == 5) {
            rowpass<1, true>(rlo, xin_x, xin_c, (const bf16_t*)(p.ws + WS_YO), l == 0 ? (const bf16_t*)(p.ws + WS_CTXB) : nullptr, p.g_post_mix + l * 1024, modl, 2, p.out, XC, p.g_pre_ffn + l * 1024, modl, 3, H);
        } else if constexpr (k == 6) {
            constexpr int M = RT - rlo;
            pg8::Gemm g{(const bf16_t*)H + (size_t)rlo * 1024, (const bf16_t*)(p.ws + WS_WF1), M, NF1, 1024, 1024}; pg8::StaticOrder S; S.init(M, NF1, G, bx);
            EpiSwiglu E{(bf16_t*)(p.ws + WS_HID) + (size_t)rlo * FH};
            pg8::gemm_phase<EpiSwiglu, pg8::StaticOrder, false, true>(lds3, g, S, E);
        } else if constexpr (k == 7) {
            {
                pg8::Gemm g{(const bf16_t*)(p.ws + WS_HID) + (size_t)RC * FH, (const bf16_t*)(p.ws + WS_WF2), RX, 1024, FH, FH}; pg8::StaticOrder S; S.init(RX, 1024, G, bx);
                EpiBf16Out E{(bf16_t*)(p.ws + WS_Y2) + (size_t)RC * 1024, 1024};
                pg8::gemm_phase<EpiBf16Out, pg8::StaticOrder, false, true>(lds3, g, S, E); }
            if constexpr (l == 0) {
#pragma unroll 1
                for (int hk = 0; hk < 2; ++hk) {
                    pg8::Gemm g{(const bf16_t*)(p.ws + WS_HID) + hk * (FH / 2), (const bf16_t*)(p.ws + WS_WF2) + hk * (FH / 2), RC, 1024, FH / 2, FH}; pg8::StaticOrder S; S.init(RC, 1024, G, (bx + G - 32 * hk) % G);
                    EpiBf16Out E{hk ? (bf16_t*)(p.ws + WS_CTXB) : (bf16_t*)(p.ws + WS_Y2), 1024};
                    pg8::gemm_phase<EpiBf16Out, pg8::StaticOrder, false, true>(lds3, g, S, E); }
            }
        } else {
            if constexpr (l == 0) { rowpass<1, true>(rlo, p.out, XC, (const bf16_t*)(p.ws + WS_Y2), (const bf16_t*)(p.ws + WS_CTXB), p.g_post_ffn, modl, 5, p.out, XC, p.g_pre_mix + 1024, MOD + (size_t)9 * 6144, 0, H); phase_convert<0>(p, 1, smem); }
            else rowpass<1, false>(rlo, p.out, XC, (const bf16_t*)(p.ws + WS_Y2), nullptr, p.g_post_ffn + 1024, modl, 5, p.out, XC, nullptr, nullptr, 0, nullptr);
        }
    }
}
template <int PH> DI void run_from(const Params& p, unsigned char* smem, PG8_LAS unsigned char* lds3, const int G, const XcdBarrier& xbar, cg::grid_group& grid) {
    run_phase<PH>(p, smem, lds3, G);
    if constexpr (PH + 1 < NPHASES) {
        if (PH == 0 && p.ph_lo < 0) grid.sync(); else xcd_barrier(xbar);
        run_from<PH + 1>(p, smem, lds3, G, xbar, grid);
    }
}
__global__ void __launch_bounds__(512) mega_fwd(Params p) {
    extern __shared__ __attribute__((aligned(16))) unsigned char smem[];
    cg::grid_group grid = cg::this_grid();
    volatile LAS unsigned* bst = (volatile LAS unsigned*)((LAS unsigned char*)smem + (LDS_BYTES - 64));
    if (threadIdx.x < 2) bst[threadIdx.x] = 0u;
    __syncthreads();
    const XcdBarrier xbar = xcd_barrier_post((unsigned*)(p.ws + WS_BAR), bst);
    run_from<0>(p, smem, (PG8_LAS unsigned char*)smem, (int)gridDim.x, xbar, grid);
}

extern "C" void kernel_launch(void* const* d_in, const int* in_sizes, int n_in, void* d_out, int out_size, void* d_ws, size_t ws_size, hipStream_t stream) {
    static int grid = 0;
    if (grid == 0) {
        if (n_in != 23 || ws_size < WS_END) { fprintf(stderr, "kernel_launch: unexpected inputs (n_in %d) or workspace too small (%zu < %zu)\n", n_in, ws_size, (size_t)WS_END); grid = -1; return; }
        int dev = 0, cus = 0, per_cu = 0;
        (void)hipGetDevice(&dev);
        (void)hipDeviceGetAttribute(&cus, hipDeviceAttributeMultiprocessorCount, dev);
        if (hipFuncSetAttribute((const void*)mega_fwd, hipFuncAttributeMaxDynamicSharedMemorySize, LDS_BYTES) != hipSuccess) { fprintf(stderr, "kernel_launch: hipFuncSetAttribute failed\n"); grid = -1; return; }
        if (hipOccupancyMaxActiveBlocksPerMultiprocessor(&per_cu, (const void*)mega_fwd, 512, LDS_BYTES) != hipSuccess || per_cu < 1) { per_cu = 1; (void)hipGetLastError(); }
        if (cus <= 0) cus = 256;
        grid = cus * per_cu;
    }
    if (grid < 0) return;
    Params p{};
    const float** pp = (const float**)&p;
    for (int i = 0; i < 23; ++i) pp[i] = (const float*)d_in[i];
    p.out = (float*)d_out; p.ws = (unsigned char*)d_ws; p.ph_lo = 0; p.ph_hi = NPHASES;
    (void)hipMemsetAsync((char*)d_ws + WS_BAR, 0, 16384, stream);
    void* args[] = {&p};
    hipError_t e = hipLaunchCooperativeKernel((const void*)mega_fwd, dim3(grid), dim3(512), args, LDS_BYTES, stream);
    if (e != hipSuccess) fprintf(stderr, "cooperative launch failed: %s (grid %d)\n", hipGetErrorString(e), grid);
}
```
